# Optimizing an MI355X kernel written in HIP

```python
import math
import jax
import jax.numpy as jnp
from jax import lax
import numpy as np


D_MODEL = 2048
BATCH = 4
SEQ = 4096
DEPTH = 2

HEAD_DIM = 128
W_A = D_MODEL // 4
CONV_A = 3
DH_B = 64
DV_B = 2 * DH_B
H_B = (3 * D_MODEL // 8) // DV_B
W_B = H_B * DV_B
ROT_DIM = DH_B // 4
ROPE_THETA = 500000.0
Q_BLOCK = 128
DK_C = HEAD_DIM
DV_C = HEAD_DIM
H_C = (3 * D_MODEL // 8) // DV_C
W_C = H_C * DV_C
CONV_C = 3
CHUNK = 64
N_BRANCH = 3
N_EXPERTS = 16
CAPACITY_FACTOR = 2
EXPERT_FF = D_MODEL // 2
EPS = 1e-6

SPLIT_SIZES = (W_A, W_A, W_A,
               H_B * 2 * DH_B, H_B * 2 * DH_B, W_B,
               H_C * DK_C, H_C * DK_C, W_C, W_C,
               H_C, H_C, H_C, H_C)
N_IN = sum(SPLIT_SIZES)

kernel_name = 'hybrid_gated_parallel_encoder'


def rms_norm(x, gain):
    xf = x.astype(jnp.float32)
    y = xf * lax.rsqrt(jnp.mean(xf * xf, axis=-1, keepdims=True) + EPS)
    return (y * gain.astype(jnp.float32)).astype(x.dtype)


def l2_normalize(x):
    xf = x.astype(jnp.float32)
    return (xf * lax.rsqrt(jnp.sum(xf * xf, axis=-1, keepdims=True) + EPS)).astype(x.dtype)


def centred_depthwise_conv(x, w):
    width = w.shape[0]
    r = width // 2
    T = x.shape[1]
    xp = jnp.pad(x, ((0, 0), (r, r), (0, 0)))
    return sum(xp[:, i:i + T] * w[i] for i in range(width))


def partial_rotary(x, cos, sin):
    half = ROT_DIM // 2
    c = cos[:, :, None, None, :].astype(x.dtype)
    s = sin[:, :, None, None, :].astype(x.dtype)
    x1 = x[..., :half]
    x2 = x[..., half:ROT_DIM]
    return jnp.concatenate([x1 * c - x2 * s, x2 * c + x1 * s, x[..., ROT_DIM:]], axis=-1)


def short_conv_mixer(b, c, v, conv_w):
    return b * centred_depthwise_conv(c * v, conv_w)


def blockwise_diff_attention(q, k, v, lam):
    B_, T, H = q.shape[:3]
    nb = T // Q_BLOCK
    qb = q.reshape(B_, nb, Q_BLOCK, H, 2, DH_B).transpose(1, 0, 3, 4, 2, 5)
    kt = k.transpose(0, 2, 3, 1, 4)
    vt = v.transpose(0, 2, 1, 3)
    scale = DH_B ** -0.5

    def one_block(qi):
        s = jnp.einsum('bhcqd,bhckd->bhcqk', qi, kt).astype(jnp.float32) * scale
        p = jax.nn.softmax(s, axis=-1)
        a = p[:, :, 0] - lam * p[:, :, 1]
        return jnp.einsum('bhqk,bhkd->bhqd', a.astype(vt.dtype), vt)

    o = lax.map(one_block, qb)
    return o.transpose(1, 0, 3, 2, 4).reshape(B_, T, H, DV_B)


def diff_attention_mixer(q, k, v, cos, sin, q_gain, k_gain, lq1, lk1, lq2, lk2, sub_gain, lam_init):
    B_, T, _ = q.shape
    q = partial_rotary(rms_norm(q.reshape(B_, T, H_B, 2, DH_B), q_gain), cos, sin)
    k = partial_rotary(rms_norm(k.reshape(B_, T, H_B, 2, DH_B), k_gain), cos, sin)
    v = v.reshape(B_, T, H_B, DV_B)
    f32 = jnp.float32
    lam = (jnp.exp(jnp.sum(lq1.astype(f32) * lk1.astype(f32)))
           - jnp.exp(jnp.sum(lq2.astype(f32) * lk2.astype(f32))) + lam_init)
    o = blockwise_diff_attention(q, k, v, lam)
    o = rms_norm(o, sub_gain) * (1.0 - lam_init)
    return o.reshape(B_, T, W_B)


def chunk_gated_delta_rule(q, k, v, g, beta):
    B_, T, H, Dk = q.shape
    Dv = v.shape[-1]
    n = T // CHUNK
    f32 = jnp.float32

    def to_chunks(t):
        return t.astype(f32).reshape(B_, n, CHUNK, H, -1).transpose(0, 3, 1, 2, 4)

    q, k, v = to_chunks(q), to_chunks(k), to_chunks(v)
    g = g.astype(f32).reshape(B_, n, CHUNK, H).transpose(0, 3, 1, 2)
    beta = beta.astype(f32).reshape(B_, n, CHUNK, H).transpose(0, 3, 1, 2)
    g = jnp.cumsum(g, axis=-1)
    incl = jnp.tril(jnp.ones((CHUNK, CHUNK), dtype=bool))
    strict = jnp.tril(jnp.ones((CHUNK, CHUNK), dtype=bool), k=-1)
    diff = g[..., :, None] - g[..., None, :]
    decay = jnp.where(incl, jnp.exp(jnp.where(incl, diff, 0.0)), 0.0)
    k_beta = k * beta[..., None]
    lower = jnp.where(strict, jnp.einsum('bhncd,bhnsd->bhncs', k_beta, k) * decay, 0.0)
    rhs = jnp.concatenate([v * beta[..., None], k_beta * jnp.exp(g)[..., None]], axis=-1)
    sol = lax.linalg.triangular_solve(jnp.eye(CHUNK, dtype=f32) + lower, rhs,
                                      left_side=True, lower=True, unit_diagonal=True)
    u, w = sol[..., :Dv], sol[..., Dv:]
    attn = jnp.einsum('bhncd,bhnsd->bhncs', q, k) * decay
    q_dec = q * jnp.exp(g)[..., None]
    k_dec = k * jnp.exp(g[..., -1:] - g)[..., None]
    g_end = jnp.exp(g[..., -1])

    def step(state, xs):
        u_i, w_i, q_i, a_i, k_i, ge_i = xs
        v_new = u_i - jnp.einsum('bhck,bhkv->bhcv', w_i, state)
        o_i = jnp.einsum('bhck,bhkv->bhcv', q_i, state) + jnp.einsum('bhcs,bhsv->bhcv', a_i, v_new)
        state = state * ge_i[..., None, None] + jnp.einsum('bhck,bhcv->bhkv', k_i, v_new)
        return state, o_i

    xs = tuple(jnp.moveaxis(t, 2, 0) for t in (u, w, q_dec, attn, k_dec, g_end))
    s0 = jnp.zeros((B_, H, Dk, Dv), f32)
    _, o = lax.scan(step, s0, xs)
    return o.transpose(1, 0, 3, 2, 4).reshape(B_, T, H, Dv)


def log_decay(a, a_log, dt_bias):
    f32 = jnp.float32
    return -jnp.exp(a_log.astype(f32)) * jax.nn.softplus(a.astype(f32) + dt_bias.astype(f32))


def gated_deltanet_mixer(q, k, v, g_out, beta_f, beta_b, a_f, a_b, conv_w,
                         a_log_f, a_log_b, dt_bias_f, dt_bias_b, o_gain):
    B_, T, _ = q.shape
    qkv = jax.nn.silu(centred_depthwise_conv(jnp.concatenate([q, k, v], axis=-1), conv_w))
    q, k, v = jnp.split(qkv, [H_C * DK_C, 2 * H_C * DK_C], axis=-1)
    q = l2_normalize(q.reshape(B_, T, H_C, DK_C)) * (DK_C ** -0.5)
    k = l2_normalize(k.reshape(B_, T, H_C, DK_C))
    v = v.reshape(B_, T, H_C, DV_C)
    o_fwd = chunk_gated_delta_rule(q, k, v, log_decay(a_f, a_log_f, dt_bias_f),
                                   jax.nn.sigmoid(beta_f.astype(jnp.float32)))
    rev = lambda t: jnp.flip(t, axis=1)
    o_bwd = rev(chunk_gated_delta_rule(rev(q), rev(k), rev(v), rev(log_decay(a_b, a_log_b, dt_bias_b)),
                                       rev(jax.nn.sigmoid(beta_b.astype(jnp.float32)))))
    o = rms_norm(o_fwd + o_bwd, o_gain) * jax.nn.silu(g_out.reshape(B_, T, H_C, DV_C).astype(jnp.float32))
    return o.astype(g_out.dtype).reshape(B_, T, W_C)


def expert_choice_ffn(h, w_router, w_gate, w_up, w_down):
    B_, T, _ = h.shape
    cap = CAPACITY_FACTOR * T // N_EXPERTS
    aff = jax.nn.softmax(jnp.einsum('btd,de->bte', h, w_router).astype(jnp.float32), axis=-1)
    weight, idx = lax.top_k(jnp.swapaxes(aff, 1, 2), cap)
    b_idx = jnp.arange(B_)[:, None, None]
    xs = h[b_idx, idx]
    hid = jax.nn.silu(jnp.einsum('becd,edf->becf', xs, w_gate)) * jnp.einsum('becd,edf->becf', xs, w_up)
    y = jnp.einsum('becf,efd->becd', hid, w_down) * weight[..., None].astype(h.dtype)
    return jnp.zeros_like(h).at[b_idx, idx].add(y)


def setup_inputs(seed: int = 0) -> dict:
    key = jax.random.key(seed)
    ks = iter(jax.random.split(key, 32))
    f32 = jnp.float32
    L, D = DEPTH, D_MODEL

    def normal(shape, scale):
        return scale * jax.random.normal(next(ks), shape, f32)

    def gain(shape):
        return 1.0 + normal(shape, 0.02)

    def dt_bias(shape):
        dt = jnp.exp(jax.random.uniform(next(ks), shape, f32, math.log(1e-3), math.log(1e-1)))
        return dt + jnp.log(-jnp.expm1(-dt))

    def a_log(shape):
        return jnp.log(jax.random.uniform(next(ks), shape, f32, 1.0, 16.0))

    x = normal((BATCH, SEQ, D), 1.0)
    positions = jnp.broadcast_to(jnp.arange(SEQ, dtype=jnp.int32), (BATCH, SEQ))
    return {
        'x': x,
        'positions': positions,
        'norm_mix': gain((L, D)),
        'w_in': normal((L, D, N_IN), D ** -0.5),
        'conv_a': normal((L, CONV_A, W_A), CONV_A ** -0.5),
        'q_norm': gain((L, DH_B)),
        'k_norm': gain((L, DH_B)),
        'lambda_q1': normal((L, DH_B), 0.1),
        'lambda_k1': normal((L, DH_B), 0.1),
        'lambda_q2': normal((L, DH_B), 0.1),
        'lambda_k2': normal((L, DH_B), 0.1),
        'subln': gain((L, DV_B)),
        'conv_c': normal((L, CONV_C, 2 * H_C * DK_C + W_C), CONV_C ** -0.5),
        'a_log_f': a_log((L, H_C)),
        'a_log_b': a_log((L, H_C)),
        'dt_bias_f': dt_bias((L, H_C)),
        'dt_bias_b': dt_bias((L, H_C)),
        'o_norm': gain((L, DV_C)),
        'w_out_a': normal((L, W_A, D), W_A ** -0.5),
        'w_out_b': normal((L, W_B, D), W_B ** -0.5),
        'w_out_c': normal((L, W_C, D), W_C ** -0.5),
        'w_gate': normal((L, D, N_BRANCH * D), D ** -0.5),
        'b_gate': normal((L, N_BRANCH * D), 0.02),
        'w_o': normal((L, D, D), D ** -0.5),
        'norm_ffn': gain((L, D)),
        'w_router': normal((L, D, N_EXPERTS), D ** -0.5),
        'w_e_gate': normal((L, N_EXPERTS, D, EXPERT_FF), D ** -0.5),
        'w_e_up': normal((L, N_EXPERTS, D, EXPERT_FF), D ** -0.5),
        'w_e_down': normal((L, N_EXPERTS, EXPERT_FF, D), EXPERT_FF ** -0.5),
    }


def reference(x, positions, norm_mix, w_in, conv_a, q_norm, k_norm, lambda_q1, lambda_k1,
              lambda_q2, lambda_k2, subln, conv_c, a_log_f, a_log_b, dt_bias_f, dt_bias_b,
              o_norm, w_out_a, w_out_b, w_out_c, w_gate, b_gate, w_o, norm_ffn, w_router,
              w_e_gate, w_e_up, w_e_down):
    inv_freq = ROPE_THETA ** (-jnp.arange(0, ROT_DIM, 2, dtype=jnp.float32) / ROT_DIM)
    ang = positions.astype(jnp.float32)[..., None] * inv_freq
    cos, sin = jnp.cos(ang), jnp.sin(ang)
    split_at = np.cumsum(SPLIT_SIZES)[:-1].tolist()
    for l in range(DEPTH):
        lam_init = 0.8 - 0.6 * math.exp(-0.3 * l)
        xn = rms_norm(x, norm_mix[l])
        (b_a, c_a, v_a, q_b, k_b, v_b, q_c, k_c, v_c, g_c,
         beta_f, beta_b, a_f, a_b) = jnp.split(xn @ w_in[l], split_at, axis=-1)
        y_a = short_conv_mixer(b_a, c_a, v_a, conv_a[l]) @ w_out_a[l]
        y_b = diff_attention_mixer(q_b, k_b, v_b, cos, sin, q_norm[l], k_norm[l],
                                   lambda_q1[l], lambda_k1[l], lambda_q2[l], lambda_k2[l],
                                   subln[l], lam_init) @ w_out_b[l]
        y_c = gated_deltanet_mixer(q_c, k_c, v_c, g_c, beta_f, beta_b, a_f, a_b, conv_c[l],
                                   a_log_f[l], a_log_b[l], dt_bias_f[l], dt_bias_b[l],
                                   o_norm[l]) @ w_out_c[l]
        g_a, g_b, g_cc = jnp.split(jax.nn.sigmoid(xn @ w_gate[l] + b_gate[l]), N_BRANCH, axis=-1)
        x = x + (g_a * y_a + g_b * y_b + g_cc * y_c) @ w_o[l]
        x = x + expert_choice_ffn(rms_norm(x, norm_ffn[l]), w_router[l],
                                  w_e_gate[l], w_e_up[l], w_e_down[l])
    return x
```

```cpp
#include <hip/hip_runtime.h>
#include <cstdio>
#include <cstdint>
#include <cmath>

#ifndef DBLP
#define DBLP 0
#endif
#ifndef DBL3MASK
#define DBL3MASK 7
#endif
#ifndef DBL
#define DBL -1
#endif
#ifndef MK_ONE_LAUNCH
#define MK_ONE_LAUNCH 1
#endif

#define LAS __attribute__((address_space(3)))
#define GAS __attribute__((address_space(1)))
typedef unsigned short bf16;
typedef short bf16x8 __attribute__((ext_vector_type(8)));
typedef short s16x4 __attribute__((ext_vector_type(4)));
typedef float f32x4 __attribute__((ext_vector_type(4)));
typedef float f32x2 __attribute__((ext_vector_type(2)));
typedef float f32x16 __attribute__((ext_vector_type(16)));
typedef unsigned u32x4 __attribute__((ext_vector_type(4)));
typedef unsigned u32x2 __attribute__((ext_vector_type(2)));
typedef __bf16 bf16x2_t __attribute__((ext_vector_type(2)));

constexpr int D = 2048, BATCH = 4, SEQ = 4096, M = BATCH * SEQ, DEPTH = 2;
constexpr int NIN = 6936, NPROJ = 6912, NGATE = 6144, NPROJ_PAD = 7168;
constexpr int WA = 512, WB = 768, WC = 768, HB = 6, HC = 6;
constexpr int NE = 16, CAP = 512, FF = 1024;
constexpr float EPS = 1e-6f;
constexpr int PC_BA = 0, PC_CA = 512, PC_VA = 1024, PC_QB = 1536, PC_KB = 2304, PC_VB = 3072, PC_QC = 3840, PC_KC = 4608, PC_VC = 5376, PC_GC = 6144;
constexpr int NCHUNK = SEQ / 64;

__device__ __forceinline__ unsigned f2bf(float f) { unsigned u = __builtin_bit_cast(unsigned, f); return (u + 0x7fffu + ((u >> 16) & 1u)) >> 16; }
__device__ __forceinline__ unsigned pk2(float lo, float hi) { f32x2 v = {lo, hi}; bf16x2_t b = __builtin_convertvector(v, bf16x2_t); return __builtin_bit_cast(unsigned, b); }
__device__ __forceinline__ float bf2f(unsigned short h) { return __builtin_bit_cast(float, (unsigned)h << 16); }
__device__ __forceinline__ float bflo(unsigned w) { return __builtin_bit_cast(float, w << 16); }
__device__ __forceinline__ float bfhi(unsigned w) { return __builtin_bit_cast(float, w & 0xffff0000u); }
__device__ __forceinline__ float sigmoidf_(float x) { return __builtin_amdgcn_rcpf(1.f + __builtin_amdgcn_exp2f(-1.4426950408889634f * x)); }
__device__ __forceinline__ float siluf_(float x) { return x * __builtin_amdgcn_rcpf(1.f + __builtin_amdgcn_exp2f(-1.4426950408889634f * x)); }
template <int O> __device__ __forceinline__ float shx(float v) {
    if constexpr (O < 32) return __builtin_bit_cast(float, __builtin_amdgcn_ds_swizzle(__builtin_bit_cast(int, v), (O << 10) | 0x1f));
    else { const unsigned u = __builtin_bit_cast(unsigned, v); auto rr = __builtin_amdgcn_permlane32_swap(u, u, false, false);
        const unsigned a = rr[0], b = rr[1]; return __builtin_bit_cast(float, a == u ? b : a); }
}
__device__ __forceinline__ float wave_sum(float v) {
    v += shx<1>(v); v += shx<2>(v); v += shx<4>(v); v += shx<8>(v); v += shx<16>(v);
    const unsigned u = __builtin_bit_cast(unsigned, v); auto rr = __builtin_amdgcn_permlane32_swap(u, u, false, false);
    return __builtin_bit_cast(float, (unsigned)rr[0]) + __builtin_bit_cast(float, (unsigned)rr[1]);
}
__device__ __forceinline__ float shfl_up_f(float v, int o, int lane) { return __builtin_bit_cast(float, __builtin_amdgcn_ds_bpermute(((lane - o) & 63) << 2, __builtin_bit_cast(int, v))); }
__device__ __forceinline__ int shfl_up_i(int v, int o, int lane) { return __builtin_amdgcn_ds_bpermute(((lane - o) & 63) << 2, v); }
#define LDS_WAIT() asm volatile("s_waitcnt lgkmcnt(0)" ::: "memory")
#define LBAR() do { asm volatile("s_waitcnt lgkmcnt(0)" ::: "memory"); __builtin_amdgcn_s_barrier(); asm volatile("" ::: "memory"); } while (0)
#define VM_WAIT() asm volatile("s_waitcnt vmcnt(0)" ::: "memory")

namespace pg8 {
constexpr int BM = 256, BK = 64, HALF = 128, HTB = HALF * BK * 2, STAGE_BYTES = 8 * HTB;
__host__ __device__ __forceinline__ int lds_byte(int r, int c) { const int st = (r >> 4) * 2 + (c >> 5), rr = r & 15, cc = c & 31, ob = rr * 64 + cc * 2; return st * 1024 + (ob ^ (((ob >> 9) & 1) << 5)); }
__host__ __device__ __forceinline__ void stage_rc(int b, int& R, int& C) { const int st = b / 1024, sb = b % 1024, swz = sb ^ (((sb >> 9) & 1) << 5); R = (st >> 1) * 16 + swz / 64; C = (st & 1) * 32 + (swz % 64) / 2; }
__host__ __device__ __forceinline__ int perm32(int rho) { const int n = rho >> 4, i = rho & 15; return 8 * (i >> 2) + 4 * n + (i & 3); }

struct Unit { const char* a; const char* b; int nt; int pm, pn, aux; };

template <class Epi, class Sched, bool GATHER = false>
__device__ __forceinline__ void gemm_phase(LAS unsigned char* lds, const int tid, const int lda, const int ldb, const Sched& S, const Epi& E) {
    const int wid = __builtin_amdgcn_readfirstlane(tid >> 6), lane = tid & 63, wr = wid >> 2, wc = wid & 3, fr = lane & 15, fq = lane >> 4;
    unsigned voffA[2], voffB[2];
#pragma unroll
    for (int i = 0; i < 2; ++i) { int R, C; stage_rc(tid * 16 + i * 8192, R, C); const int Rb = Epi::PERM ? ((R & ~31) + perm32(R & 31)) : R;
        voffA[i] = (unsigned)(R * lda + C) * 2u; voffB[i] = (unsigned)(Rb * ldb + C) * 2u; }
    const size_t kstep = (size_t)(BK * 2);
    const size_t hstepA = (size_t)HALF * lda * 2, hstepB = (size_t)HALF * ldb * 2;
    const unsigned ldsw = (unsigned)wid * 1024u;
    const int aoff = lds_byte(wr * 64 + fr, fq * 8), boff = lds_byte(wc * 32 + fr, fq * 8);
#define PG8_SA(b, h) (((b) * 2 + (h)) * HTB)
#define PG8_SB(b, h) ((4 + (b) * 2 + (h)) * HTB)
#define PG8_STAGE(bufoff, gbase, voff) do { _Pragma("unroll") for (int _i = 0; _i < 2; ++_i) \
        __builtin_amdgcn_global_load_lds((const unsigned*)((const char*)(gbase) + (voff)[_i]), (LAS unsigned*)(lds + (bufoff) + ldsw + _i * 8192), 16, 0, 0); } while (0)
#define PG8_LDA(dst, b, h) do { _Pragma("unroll") for (int m = 0; m < 4; ++m) _Pragma("unroll") for (int k = 0; k < 2; ++k) dst[m][k] = *(const LAS bf16x8*)(lds + PG8_SA(b, h) + aoff + m * 2048 + k * 1024); } while (0)
#define PG8_LDB(dst, b, h) do { _Pragma("unroll") for (int n = 0; n < 2; ++n) _Pragma("unroll") for (int k = 0; k < 2; ++k) dst[n][k] = *(const LAS bf16x8*)(lds + PG8_SB(b, h) + boff + n * 2048 + k * 1024); } while (0)
#define PG8_MMA(ai, bj, At, Bt) do { __builtin_amdgcn_s_setprio(1); _Pragma("unroll") for (int m = 0; m < 4; ++m) _Pragma("unroll") for (int n = 0; n < 2; ++n) _Pragma("unroll") for (int k = 0; k < 2; ++k) \
        acc[ai][bj][m][n] = __builtin_amdgcn_mfma_f32_16x16x32_bf16(Bt[n][k], At[m][k], acc[ai][bj][m][n], 0, 0, 0); __builtin_amdgcn_s_setprio(0); } while (0)
#define PG8_WAIT_V(n) asm volatile("s_waitcnt vmcnt(" #n ")" ::: "memory")
#define PG8_WAIT_L(n) asm volatile("s_waitcnt lgkmcnt(" #n ")" ::: "memory")
#define PG8_BAR __builtin_amdgcn_s_barrier()
#define PG8_SCHED __builtin_amdgcn_sched_barrier(0)
    Unit cur, nxt; int ui = 0;
    if (!S.next(0, cur)) return;
    f32x4 acc[2][2][4][2];
#pragma unroll
    for (int a = 0; a < 2; ++a)
#pragma unroll
        for (int b = 0; b < 2; ++b)
#pragma unroll
            for (int m = 0; m < 4; ++m)
#pragma unroll
                for (int n = 0; n < 2; ++n) acc[a][b][m][n] = (f32x4){0.f, 0.f, 0.f, 0.f};
    bf16x8 At[4][2], B0[2][2], B1[2][2];
    const char* cA = cur.a; const char* cB = cur.b;
    unsigned cv[2][2], nv[2][2];
#pragma unroll
    for (int i = 0; i < 2; ++i) { cv[0][i] = voffA[i]; cv[1][i] = voffA[i] + (unsigned)hstepA; nv[0][i] = cv[0][i]; nv[1][i] = cv[1][i]; }
    auto gather_offs = [&](const Unit& u, unsigned (&v)[2][2]) {
#pragma unroll
        for (int h = 0; h < 2; ++h)
#pragma unroll
            for (int i = 0; i < 2; ++i) { int R, C; stage_rc(tid * 16 + i * 8192, R, C); v[h][i] = (unsigned)(S.row_index(u, h * HALF + R) * lda + C) * 2u; } };
    if constexpr (GATHER) { gather_offs(cur, cv); }
    PG8_STAGE(PG8_SB(0, 0), cB, voffB); PG8_STAGE(PG8_SB(0, 1), cB + hstepB, voffB); PG8_STAGE(PG8_SA(0, 0), cA, cv[0]); PG8_STAGE(PG8_SA(0, 1), cA, cv[1]);
    if (wr == 1) PG8_BAR;
    PG8_WAIT_V(2); PG8_BAR;
    PG8_STAGE(PG8_SB(1, 0), cB + kstep, voffB); PG8_STAGE(PG8_SA(1, 0), cA + kstep, cv[0]); PG8_STAGE(PG8_SB(1, 1), cB + hstepB + kstep, voffB);
    PG8_WAIT_V(6); PG8_BAR;
    for (;;) {
        const bool has_next = S.next(ui + 1, nxt);
        const char* nA = has_next ? nxt.a : cA; const char* nB = has_next ? nxt.b : cB;
        if constexpr (GATHER) { if (has_next) gather_offs(nxt, nv); else {
#pragma unroll
            for (int h = 0; h < 2; ++h)
#pragma unroll
                for (int i = 0; i < 2; ++i) nv[h][i] = cv[h][i]; } }
        const int nt = cur.nt;
        for (int t = 0; t < nt; t += 2) {
            const bool last = (t == nt - 2);
            const char* a1 = cA + (size_t)(t + 1) * kstep;
            const char* a2 = last ? nA : cA + (size_t)(t + 2) * kstep; const char* b2 = last ? nB : cB + (size_t)(t + 2) * kstep;
            const char* a3 = a2 + kstep; const char* b3 = b2 + kstep;
            unsigned s0[2], s1[2];
#pragma unroll
            for (int i = 0; i < 2; ++i) { s0[i] = (GATHER && last) ? nv[0][i] : cv[0][i]; s1[i] = (GATHER && last) ? nv[1][i] : cv[1][i]; }
            PG8_LDB(B0, 0, 0); PG8_LDB(B1, 0, 1); PG8_SCHED; PG8_LDA(At, 0, 0); PG8_STAGE(PG8_SA(1, 1), a1, cv[1]);
            PG8_WAIT_V(8); PG8_WAIT_L(0); PG8_BAR; PG8_MMA(0, 0, At, B0); PG8_MMA(0, 1, At, B1); PG8_BAR; PG8_SCHED;
            PG8_LDA(At, 0, 1); PG8_STAGE(PG8_SB(0, 0), b2, voffB); PG8_STAGE(PG8_SB(0, 1), b2 + hstepB, voffB); PG8_STAGE(PG8_SA(0, 0), a2, s0);
            PG8_WAIT_V(8); PG8_WAIT_L(0); PG8_BAR; PG8_MMA(1, 0, At, B0); PG8_MMA(1, 1, At, B1); PG8_BAR; PG8_SCHED;
            PG8_LDB(B0, 1, 0); PG8_LDB(B1, 1, 1); PG8_SCHED; PG8_LDA(At, 1, 0); PG8_STAGE(PG8_SA(0, 1), a2, s1);
            PG8_WAIT_V(8); PG8_WAIT_L(0); PG8_BAR; PG8_MMA(0, 0, At, B0); PG8_MMA(0, 1, At, B1); PG8_BAR; PG8_SCHED;
            PG8_LDA(At, 1, 1); PG8_STAGE(PG8_SB(1, 0), b3, voffB); PG8_STAGE(PG8_SB(1, 1), b3 + hstepB, voffB); PG8_STAGE(PG8_SA(1, 0), a3, s0);
            PG8_WAIT_V(8); PG8_WAIT_L(0); PG8_BAR; PG8_MMA(1, 0, At, B0); PG8_MMA(1, 1, At, B1); PG8_BAR; PG8_SCHED;
        }
        if (wr == 0) PG8_BAR;
        E(acc, cur, wr, wc, fr, fq);
        if (!has_next) break;
#pragma unroll
        for (int a = 0; a < 2; ++a)
#pragma unroll
            for (int b = 0; b < 2; ++b)
#pragma unroll
                for (int m = 0; m < 4; ++m)
#pragma unroll
                    for (int n = 0; n < 2; ++n) acc[a][b][m][n] = (f32x4){0.f, 0.f, 0.f, 0.f};
        cur = nxt; cA = nA; cB = nB; ++ui;
        if constexpr (GATHER) {
#pragma unroll
            for (int h = 0; h < 2; ++h)
#pragma unroll
                for (int i = 0; i < 2; ++i) cv[h][i] = nv[h][i]; }
        if (wr == 1) PG8_BAR;
    }
    PG8_WAIT_V(0);
    PG8_BAR;
#undef PG8_SA
#undef PG8_SB
#undef PG8_STAGE
#undef PG8_LDA
#undef PG8_LDB
#undef PG8_MMA
#undef PG8_WAIT_V
#undef PG8_WAIT_L
#undef PG8_BAR
#undef PG8_SCHED
}
}

constexpr size_t MiB = 1u << 20;
constexpr size_t WS_CTL = 0, CTL_ZERO_BYTES = 1 * MiB;
constexpr size_t WS_W1T = 1 * MiB;
constexpr size_t WS_WGT = 29 * MiB;
constexpr size_t WS_WOUTT = 53 * MiB;
constexpr size_t WS_WOT = 61 * MiB;
constexpr size_t WS_WGU = 69 * MiB;
constexpr size_t WS_WDN = 197 * MiB;
constexpr size_t WS_WRT = 261 * MiB;
constexpr size_t WS_XN = 262 * MiB;
constexpr size_t WS_PROJ = 326 * MiB;
constexpr size_t WS_HID = WS_PROJ;
constexpr size_t WS_YSLOT = WS_PROJ + 64 * MiB;
constexpr size_t WS_SCAL = 542 * MiB;
constexpr size_t WS_MMIX = 544 * MiB;
constexpr size_t WS_QKB = 608 * MiB;
constexpr size_t WS_SCANOP = 656 * MiB;
constexpr size_t WS_Z = WS_SCANOP;
constexpr size_t WS_ZACC = WS_SCANOP + 64 * MiB;
constexpr size_t WS_XS = WS_SCANOP;
constexpr size_t WS_OF = 872 * MiB;
constexpr size_t WS_OB = 920 * MiB;
constexpr size_t WS_AFF = 968 * MiB;
constexpr size_t WS_SEL = 969 * MiB;
constexpr size_t WS_IDX = 970 * MiB;
constexpr size_t WS_EW = 970 * MiB + 512 * 1024;
constexpr size_t WS_GATES = 972 * MiB;
constexpr size_t WS_END = 1164 * MiB;
static_assert(WS_WGT == WS_W1T + (size_t)NPROJ_PAD * D * 2, "W_in^T and W_gate^T form one [13312][2048] B matrix");
constexpr int SCANOP_BYTES = 73728;
constexpr int SO_W = 0, SO_Q = 16384, SO_K = 32768, SO_A = 49152, SO_U = 57344;
constexpr int CW_TMO = 0, CW_BAR = 4096, CW_Q = 8192;

constexpr int LDS_BYTES = 163840, MISC_OFF = 163584;
static_assert(pg8::STAGE_BYTES <= MISC_OFF, "lds");

#define RLX_AGENT __ATOMIC_RELAXED, __HIP_MEMORY_SCOPE_AGENT
#define XB_TMO      128
#define XB_XCNT(j)  (256  + 64 * (j))
#define XB_XSUB(j)  (1280 + 64 * (j))
#define XB_XGEN(j)  (2304 + 64 * (j))
#define XB_TOP      3328
#define XB_TOPGEN   3392
#define XCD_BAR_WORDS 3456
#define XB_SPIN_CAP (1u << 18)
__device__ __forceinline__ unsigned xb_ld(unsigned* p)              { return __hip_atomic_load(p, __ATOMIC_RELAXED, __HIP_MEMORY_SCOPE_AGENT); }
__device__ __forceinline__ unsigned xb_add(unsigned* p, unsigned v) { return __hip_atomic_fetch_add(p, v, __ATOMIC_RELAXED, __HIP_MEMORY_SCOPE_AGENT); }
__device__ __forceinline__ unsigned xb_xcc_id() { return (unsigned)__builtin_amdgcn_s_getreg((3 << 11) | 20) & 0xFu; }
#define XB_SPIN(cond, bar) do { unsigned _sp = 0; while (cond) { __builtin_amdgcn_s_sleep(1); \
    if ((++_sp & 255u) == 0u) { if (xb_ld(&(bar)[XB_TMO])) break; if (_sp > XB_SPIN_CAP) { atomicAdd(&(bar)[XB_TMO], 1u); break; } } } } while (0)
struct XcdBarrier { unsigned* bar; unsigned x; volatile LAS unsigned* st; };
__device__ __forceinline__ XcdBarrier xcd_barrier_post(unsigned* bar, volatile LAS unsigned* st, int tid) {
    XcdBarrier b; b.bar = bar; b.x = xb_xcc_id(); b.st = st;
    if (tid == 0) (void)xb_add(&bar[XB_XCNT(b.x)], 1u);
    return b;
}
__device__ __forceinline__ void xcd_barrier_complete(unsigned* bar, unsigned x, unsigned& nloc, unsigned& nx) {
    const unsigned G = gridDim.x * gridDim.y * gridDim.z;
    unsigned sum, cnt, mine, sp = 0u;
    for (;;) {
        sum = 0u; cnt = 0u; mine = 0u;
#pragma unroll 1
        for (unsigned j = 0; j < 16; ++j) { const unsigned c = xb_ld(&bar[XB_XCNT(j)]); sum += c; cnt += (c > 0u) ? 1u : 0u; mine = (j == x) ? c : mine; }
        if (sum == G) break;
        __builtin_amdgcn_s_sleep(1);
        if ((++sp & 255u) == 0u) { if (xb_ld(&bar[XB_TMO])) break; if (sp > XB_SPIN_CAP) { atomicAdd(&bar[XB_TMO], 1u); break; } }
    }
    nloc = mine > 0u ? mine : 1u; nx = cnt > 0u ? cnt : 1u;
}
__device__ __forceinline__ void xcd_barrier(const XcdBarrier& b, int tid) {
    asm volatile("s_waitcnt vmcnt(0)" ::: "memory");
    __syncthreads();
    if (tid == 0) {
        unsigned* bar = b.bar;
        __builtin_amdgcn_s_waitcnt(0);
        unsigned nloc = b.st[0], nx = b.st[1];
        if (nloc == 0u) { xcd_barrier_complete(bar, b.x, nloc, nx); b.st[0] = nloc; b.st[1] = nx; }
        const unsigned old = xb_add(&bar[XB_XSUB(b.x)], 1u);
        const unsigned gen = old / nloc;
        if (old + 1u == (gen + 1u) * nloc) {
            __builtin_amdgcn_fence(__ATOMIC_RELEASE, "agent");
            asm volatile("s_waitcnt vmcnt(0)" ::: "memory");
            const unsigned og = xb_add(&bar[XB_TOP], 1u);
            const unsigned tg = og / nx;
            if (og + 1u == (tg + 1u) * nx) xb_add(&bar[XB_TOPGEN], 1u);
            else XB_SPIN(xb_ld(&bar[XB_TOPGEN]) == tg, bar);
            __builtin_amdgcn_fence(__ATOMIC_ACQUIRE, "agent");
            xb_add(&bar[XB_XGEN(b.x)], 1u);
            asm volatile("s_waitcnt vmcnt(0)" ::: "memory");
        } else {
            XB_SPIN(xb_ld(&bar[XB_XGEN(b.x)]) == gen, bar);
            __builtin_amdgcn_fence(__ATOMIC_ACQUIRE, "agent");
            asm volatile("s_waitcnt vmcnt(0)" ::: "memory");
        }
    }
    __syncthreads();
}

struct Args { const void* in[29]; float* out; unsigned char* ws; int ph_lo, ph_hi; };
typedef const Args __attribute__((address_space(4)))* ArgsP;
struct Frame {
    LAS unsigned char* lds;
    unsigned char* ws;
    unsigned* ctl;
    int tid, lane, wave, bid, G;
};

struct CvtRegs { f32x4 v[8]; };
__device__ __forceinline__ void cvt_load(CvtRegs& r, const float* W, int ldw, int n0, int Nvalid, int k0, int lane) {
    const int rs = lane >> 3, c4 = lane & 7; const bool ok = (n0 + 4 * c4) < Nvalid;
#pragma unroll
    for (int i = 0; i < 8; ++i) { const f32x4 t = *(const f32x4*)(W + (size_t)(k0 + 8 * i + rs) * ldw + (ok ? n0 + 4 * c4 : 0)); r.v[i] = ok ? t : (f32x4){0.f, 0.f, 0.f, 0.f}; }
}
__device__ __forceinline__ void cvt_store(const CvtRegs& r, bf16* dst, int ldt, LAS float* scr, int lane) {
    const int rs = lane >> 3, c4 = lane & 7;
#pragma unroll
    for (int i = 0; i < 8; ++i) { LAS float* p = scr + (8 * i + rs) * 33 + 4 * c4; p[0] = r.v[i].x; p[1] = r.v[i].y; p[2] = r.v[i].z; p[3] = r.v[i].w; }
    LDS_WAIT(); asm volatile("" ::: "memory");
    const int c = lane & 7;
#pragma unroll
    for (int j = 0; j < 4; ++j) { const int n = (lane >> 3) + 8 * j; const LAS float* s = scr + (8 * c) * 33 + n;
        u32x4 o; o.x = pk2(s[0 * 33], s[1 * 33]); o.y = pk2(s[2 * 33], s[3 * 33]); o.z = pk2(s[4 * 33], s[5 * 33]); o.w = pk2(s[6 * 33], s[7 * 33]);
        *(u32x4*)(dst + (size_t)n * ldt + 8 * c) = o; }
    LDS_WAIT(); asm volatile("" ::: "memory");
}
struct CvtItem { const float* W; bf16* dst; int ldw, n0, Nvalid, k0, ldt; };
__device__ __forceinline__ CvtItem small_item(unsigned char* ws, ArgsP A, int l, int r) {
    constexpr int I0 = 32 * 224, I1 = 32 * 192, I2 = 8 * 64, I3 = 12 * 64, I4 = 12 * 64;
    CvtItem it;
    if (r < I0) { const int kb = r / 224, nb = r % 224; it = CvtItem{(const float*)A->in[3] + (size_t)l * D * NIN, (bf16*)(ws + WS_W1T) + (size_t)(32 * nb) * D + 64 * kb, NIN, 32 * nb, NIN, 64 * kb, D}; return it; } r -= I0;
    if (r < I1) { const int kb = r / 192, nb = r % 192; it = CvtItem{(const float*)A->in[21] + (size_t)l * D * NGATE, (bf16*)(ws + WS_WGT) + (size_t)(32 * nb) * D + 64 * kb, NGATE, 32 * nb, NGATE, 64 * kb, D}; return it; } r -= I1;
    if (r < I2) { const int kb = r / 64, nb = r % 64; it = CvtItem{(const float*)A->in[18] + (size_t)l * WA * D, (bf16*)(ws + WS_WOUTT) + (size_t)(32 * nb) * D + 0 + 64 * kb, D, 32 * nb, D, 64 * kb, D}; return it; } r -= I2;
    if (r < I3) { const int kb = r / 64, nb = r % 64; it = CvtItem{(const float*)A->in[19] + (size_t)l * WB * D, (bf16*)(ws + WS_WOUTT) + (size_t)(32 * nb) * D + 512 + 64 * kb, D, 32 * nb, D, 64 * kb, D}; return it; } r -= I3;
    if (r < I4) { const int kb = r / 64, nb = r % 64; it = CvtItem{(const float*)A->in[20] + (size_t)l * WC * D, (bf16*)(ws + WS_WOUTT) + (size_t)(32 * nb) * D + 1280 + 64 * kb, D, 32 * nb, D, 64 * kb, D}; return it; } r -= I4;
    { const int kb = r / 64, nb = r % 64; it = CvtItem{(const float*)A->in[23] + (size_t)l * D * D, (bf16*)(ws + WS_WOT) + (size_t)(32 * nb) * D + 64 * kb, D, 32 * nb, D, 64 * kb, D}; return it; }
}
__device__ __forceinline__ void phase_convert(const Frame& F, ArgsP A, int l) {
    LAS float* scr = (LAS float*)(F.lds + F.wave * 8704);
    const int gw = F.bid * 8 + F.wave, NGW = F.G * 8;
    unsigned char* ws = F.ws;
    constexpr int NIT = 32 * 224 + 32 * 192 + 8 * 64 + 12 * 64 + 12 * 64 + 32 * 64;
    CvtRegs cur, nxt; CvtItem ci, ni;
    int it = gw;
    if (it < NIT) { ci = small_item(ws, A, l, it); cvt_load(cur, ci.W, ci.ldw, ci.n0, ci.Nvalid, ci.k0, F.lane); }
    for (; it < NIT; it += NGW) {
        const bool more = it + NGW < NIT;
        if (more) { ni = small_item(ws, A, l, it + NGW); cvt_load(nxt, ni.W, ni.ldw, ni.n0, ni.Nvalid, ni.k0, F.lane); }
        cvt_store(cur, ci.dst, ci.ldt, scr, F.lane);
        if (more) { cur = nxt; ci = ni; }
    }
    const float* w_r = (const float*)A->in[25] + (size_t)l * D * NE;
    float* wrt = (float*)(ws + WS_WRT);
    for (int i = F.bid * 512 + F.tid; i < D * NE; i += F.G * 512) { const int e = i >> 11, k = i & 2047; wrt[i] = w_r[k * NE + e]; }
}
constexpr int N_CVT_UNITS = 768;
__device__ __forceinline__ CvtItem expert_item(unsigned char* ws, ArgsP A, int l, int r) {
    CvtItem it;
    if (r < 32768) { const int up = r >= 16384; if (up) r -= 16384; const int e = r >> 10, kb = (r & 1023) >> 5, nb = r & 31, n0 = 32 * nb;
        const int row = (n0 >> 7) * 256 + (n0 & 127) + up * 128;
        it = CvtItem{(const float*)A->in[up ? 27 : 26] + ((size_t)l * NE + e) * D * FF, (bf16*)(ws + WS_WGU) + ((size_t)e * 2048 + row) * D + 64 * kb, FF, n0, FF, 64 * kb, D};
    } else { r -= 32768; const int e = r >> 10, kb = (r & 1023) >> 6, nb = r & 63;
        it = CvtItem{(const float*)A->in[28] + ((size_t)l * NE + e) * FF * D, (bf16*)(ws + WS_WDN) + ((size_t)e * 2048 + 32 * nb) * FF + 64 * kb, D, 32 * nb, D, 64 * kb, FF}; }
    return it;
}
__device__ __forceinline__ void convert_expert_unit(const Frame& F, ArgsP A, int l, int cu) {
    LAS float* scr = (LAS float*)(F.lds + F.wave * 8704);
    unsigned char* ws = F.ws;
    const int r0 = cu * 64 + F.wave * 8;
    CvtRegs cur, nxt; CvtItem ci = expert_item(ws, A, l, r0), ni;
    cvt_load(cur, ci.W, ci.ldw, ci.n0, ci.Nvalid, ci.k0, F.lane);
#pragma unroll 1
    for (int k = 0; k < 8; ++k) {
        if (k + 1 < 8) { ni = expert_item(ws, A, l, r0 + k + 1); cvt_load(nxt, ni.W, ni.ldw, ni.n0, ni.Nvalid, ni.k0, F.lane); }
        cvt_store(cur, ci.dst, ci.ldt, scr, F.lane);
        if (k + 1 < 8) { cur = nxt; ci = ni; }
    }
}
__device__ __forceinline__ void rms_row_to_bf16(const float* xrow, const float* gain, bf16* orow, int lane) {
    const f32x4* xr = (const f32x4*)xrow + lane; const f32x4* gr = (const f32x4*)gain + lane;
    f32x4 v[8]; float s = 0.f;
#pragma unroll
    for (int j = 0; j < 8; ++j) { v[j] = xr[64 * j]; s += (v[j].x * v[j].x + v[j].y * v[j].y) + (v[j].z * v[j].z + v[j].w * v[j].w); }
    const float rstd = 1.f / sqrtf(wave_sum(s) * (1.f / D) + EPS);
    u32x2* o = (u32x2*)orow + lane;
#pragma unroll
    for (int j = 0; j < 8; ++j) { const f32x4 g = gr[64 * j]; u32x2 w; w.x = pk2(v[j].x * rstd * g.x, v[j].y * rstd * g.y); w.y = pk2(v[j].z * rstd * g.z, v[j].w * rstd * g.w); o[64 * j] = w; }
}
__device__ __forceinline__ void phase_rms_x(const Frame& F, const float* x, const float* gain) {
    const int gw = F.bid * 8 + F.wave, NGW = F.G * 8;
    for (int m = gw; m < M; m += NGW) rms_row_to_bf16(x + (size_t)m * D, gain, (bf16*)(F.ws + WS_XN) + (size_t)m * D, F.lane);
}

__device__ __forceinline__ int krow(int s, int h, int j) { return 16 * s + 8 * (j >> 2) + 4 * h + (j & 3); }
__device__ __forceinline__ int crow(int reg, int h) { return (reg & 3) + 8 * (reg >> 2) + 4 * h; }
__device__ __forceinline__ float softplusf_(float x) { return x > 20.f ? x : log1pf(expf(x)); }

#define MFMA32(a, b, c) __builtin_amdgcn_mfma_f32_32x32x16_bf16((a), (b), (c), 0, 0, 0)
__device__ __forceinline__ bf16x8 pack8(const f32x16& x, int s) {
    u32x4 p; p.x = pk2(x[8 * s + 0], x[8 * s + 1]); p.y = pk2(x[8 * s + 2], x[8 * s + 3]); p.z = pk2(x[8 * s + 4], x[8 * s + 5]); p.w = pk2(x[8 * s + 6], x[8 * s + 7]);
    return __builtin_bit_cast(bf16x8, p);
}
typedef short v4i16_t __attribute__((ext_vector_type(4)));
constexpr int NP_K = 0, NP_Q = 16384, NP_V = 32768, NP_L = 49152, NP_T = 83968, NP_TAB = 139264, NP_CS = 141824, NP_END = 145920;
constexpr int LP = 68;
constexpr int TP = 144;
static_assert(NP_END <= MISC_OFF, "prep lds");
__device__ __forceinline__ int swzf(int row) { return ((row & 3) << 2) | ((row >> 2) & 3); }
__device__ __forceinline__ bf16x8 img_frag(const LAS unsigned char* img, int row, int s, int hh) {
    return *(const LAS bf16x8*)(img + row * 256 + (((2 * s + hh) ^ swzf(row)) << 4)); }
__device__ __forceinline__ s16x4 tr_read4(const LAS unsigned char* p) { return __builtin_bit_cast(s16x4, __builtin_amdgcn_ds_read_tr16_b64_v4i16((LAS v4i16_t*)p)); }
__device__ __forceinline__ bf16x8 img_frag_tr(const LAS unsigned char* img, int s, int cb, int lane, int flip) {
    const int hh = lane >> 5, i16 = lane & 15, q_ = i16 >> 2, p = i16 & 3, blk = (lane >> 4) & 1;
    const int c0 = 16 * s + 4 * hh + q_, r0 = flip ? 63 - c0 : c0, r1 = flip ? 55 - c0 : c0 + 8;
    const int chunk = 4 * cb + 2 * blk + (p >> 1), within = 8 * (p & 1);
    const s16x4 lo = tr_read4(img + r0 * 256 + ((chunk ^ swzf(r0)) << 4) + within), hi = tr_read4(img + r1 * 256 + ((chunk ^ swzf(r1)) << 4) + within);
    return (bf16x8){lo[0], lo[1], lo[2], lo[3], hi[0], hi[1], hi[2], hi[3]};
}

__device__ __forceinline__ void phase_prep(Frame& F, ArgsP A, int l) {
    int& tid = F.tid; int lane = F.lane, wave = F.wave;
    unsigned char* ws = F.ws;
    const bf16* PROJ = (const bf16*)(ws + WS_PROJ);
    bf16* MMIX = (bf16*)(ws + WS_MMIX);
    bf16* QKB = (bf16*)(ws + WS_QKB);
#define RELAUNDER() do { asm volatile("" : "+v"(tid)); lane = tid & 63; wave = __builtin_amdgcn_readfirstlane(tid >> 6); } while (0)
    const float* SCAL = (const float*)(ws + WS_SCAL);
    const float* conv_c = (const float*)A->in[12] + (size_t)l * 3 * 2304;
    LAS float* cs = (LAS float*)(F.lds + NP_CS);

    for (int unit = F.bid; unit < BATCH * NCHUNK; unit += F.G) {
        const int b = unit >> 6, chunk = unit & 63, t0 = chunk * 64, m0 = b * SEQ + t0;
        const bf16* P0 = PROJ + (size_t)m0 * NPROJ;
        RELAUNDER();
#ifndef NO_PREP_AB
#pragma unroll 1
        for (int rab_ = 0; rab_ < (DBLP == 1 ? 2 : 1); ++rab_) {
        {
            const float* conv_a = (const float*)A->in[4] + (size_t)l * 3 * WA;
#pragma unroll 1
            for (int k = 0; k < 4; ++k) {
                const int it = tid + 512 * k, rg = it >> 8, cp = it & 255, r0 = 8 * rg;
                const f32x2 w0 = *(const f32x2*)(conv_a + 0 * WA + 2 * cp), w1 = *(const f32x2*)(conv_a + 1 * WA + 2 * cp), w2 = *(const f32x2*)(conv_a + 2 * WA + 2 * cp);
                unsigned cr[10], vr[10], br[8];
#pragma unroll
                for (int i = 0; i < 10; ++i) { const int r = r0 - 1 + i, t = t0 + r; const bool ok = (t >= 0 && t < SEQ); const bf16* row = P0 + (ptrdiff_t)(ok ? r : r0) * NPROJ;
                    const unsigned c = *(const unsigned*)(row + PC_CA + 2 * cp), v = *(const unsigned*)(row + PC_VA + 2 * cp); cr[i] = ok ? c : 0u; vr[i] = ok ? v : 0u; }
#pragma unroll
                for (int i = 0; i < 8; ++i) br[i] = *(const unsigned*)(P0 + (size_t)(r0 + i) * NPROJ + PC_BA + 2 * cp);
                f32x2 cv[10];
#pragma unroll
                for (int i = 0; i < 10; ++i) cv[i] = (f32x2){bflo(cr[i]) * bflo(vr[i]), bfhi(cr[i]) * bfhi(vr[i])};
#pragma unroll
                for (int i = 0; i < 8; ++i) { const f32x2 y = w0 * cv[i] + w1 * cv[i + 1] + w2 * cv[i + 2];
                    *(unsigned*)(MMIX + (size_t)(m0 + r0 + i) * D + 2 * cp) = pk2(bflo(br[i]) * y.x, bfhi(br[i]) * y.y); }
            }
        }
        RELAUNDER();
        {
            const float* q_norm = (const float*)A->in[5] + l * 64; const float* k_norm = (const float*)A->in[6] + l * 64;
            { const int row = tid >> 3, j = tid & 7; const int pos = ((const int*)A->in[1])[m0 + row];
              const float inv = powf(500000.f, -(float)(2 * j) / 16.f); const float ang = (float)pos * inv;
              cs[row * 16 + j] = cosf(ang); cs[row * 16 + 8 + j] = sinf(ang); }
            __syncthreads();
            const int e8 = lane & 7;
#pragma unroll 1
            for (int it0 = 0; it0 < 24; it0 += 4) {
                u32x4 raws[4];
#pragma unroll
                for (int j = 0; j < 4; ++j) { const int v = (it0 + j) * 64 + wave * 8 + (lane >> 3); const int row = v / 24, vv = v % 24; const int isk = vv >= 12, hc = vv % 12;
                    raws[j] = *(const u32x4*)(P0 + (size_t)row * NPROJ + (isk ? PC_KB : PC_QB) + hc * 64 + 8 * e8); }
#pragma unroll
                for (int j = 0; j < 4; ++j) {
                const int v = (it0 + j) * 64 + wave * 8 + (lane >> 3); const int row = v / 24, vv = v % 24; const int isk = vv >= 12, hc = vv % 12;
                const u32x4 raw = raws[j];
                float x[8]; x[0] = bflo(raw.x); x[1] = bfhi(raw.x); x[2] = bflo(raw.y); x[3] = bfhi(raw.y); x[4] = bflo(raw.z); x[5] = bfhi(raw.z); x[6] = bflo(raw.w); x[7] = bfhi(raw.w);
                float ss = 0.f;
#pragma unroll
                for (int i = 0; i < 8; ++i) ss += x[i] * x[i];
                ss += shx<1>(ss); ss += shx<2>(ss); ss += shx<4>(ss);
                const float rstd = 1.f / sqrtf(ss * (1.f / 64.f) + EPS);
                const float* gn = (isk ? k_norm : q_norm) + 8 * e8;
                float y[8], oth[8];
#pragma unroll
                for (int i = 0; i < 8; ++i) y[i] = x[i] * rstd * gn[i];
#pragma unroll
                for (int i = 0; i < 8; ++i) oth[i] = shx<1>(y[i]);
                if (e8 < 2) {
#pragma unroll
                    for (int i = 0; i < 8; ++i) { const float c = cs[row * 16 + i], s = cs[row * 16 + 8 + i];
                        y[i] = (e8 == 0) ? (y[i] * c - oth[i] * s) : (y[i] * c + oth[i] * s); }
                }
                const float sc = isk ? 1.f : 0.125f * 1.4426950408889634f;
                u32x4 o; o.x = pk2(y[0] * sc, y[1] * sc); o.y = pk2(y[2] * sc, y[3] * sc); o.z = pk2(y[4] * sc, y[5] * sc); o.w = pk2(y[6] * sc, y[7] * sc);
                *(u32x4*)(QKB + (size_t)(m0 + row) * 1536 + (isk ? 768 : 0) + hc * 64 + 8 * e8) = o;
                }
            }
        }
        __syncthreads(); }
#endif
#ifndef NO_PREP_C
        unsigned raw[3][10];
        auto fetch_raw = [&](int hh_) {
#pragma unroll
            for (int mat = 0; mat < 3; ++mat) { const int col = (mat == 0 ? PC_QC : (mat == 1 ? PC_KC : PC_VC)) + hh_ * 128 + 2 * lane;
#pragma unroll
                for (int i = 0; i < 10; ++i) { const int r = 8 * wave - 1 + i, t = t0 + r; const bool ok = (t >= 0 && t < SEQ);
                    const unsigned w = *(const unsigned*)(P0 + (ptrdiff_t)(ok ? r : 8 * wave) * NPROJ + col); raw[mat][i] = ok ? w : 0u; } } };
        fetch_raw(0);
#pragma unroll 1
        for (int hx = 0; hx < (DBLP == 2 ? 2 * HC : HC); ++hx) { const int h = hx % HC;
            LBAR();
            RELAUNDER();
            LAS unsigned char* kimg = F.lds + NP_K; LAS unsigned char* qimg = F.lds + NP_Q; LAS unsigned char* vimg = F.lds + NP_V;
            {
#pragma unroll
                for (int mat = 0; mat < 3; ++mat) {
                    const int wch = mat * 768 + h * 128 + 2 * lane;
                    const f32x2 cw0 = *(const f32x2*)(conv_c + 0 * 2304 + wch), cw1 = *(const f32x2*)(conv_c + 1 * 2304 + wch), cw2 = *(const f32x2*)(conv_c + 2 * 2304 + wch);
                    LAS unsigned char* img = F.lds + (mat == 0 ? NP_Q : (mat == 1 ? NP_K : NP_V));
                    f32x2 xr[10];
#pragma unroll
                    for (int i = 0; i < 10; ++i) xr[i] = (f32x2){bflo(raw[mat][i]), bfhi(raw[mat][i])};
#pragma unroll
                    for (int i = 0; i < 8; ++i) { const int row = 8 * wave + i;
                        f32x2 a = cw0 * xr[i] + cw1 * xr[i + 1] + cw2 * xr[i + 2]; a.x = siluf_(a.x); a.y = siluf_(a.y);
                        if (mat < 2) { const float ss = wave_sum(a.x * a.x + a.y * a.y); const float sc = (1.f / sqrtf(ss + EPS)) * (mat == 0 ? 0.08838834764831845f : 1.f); a.x *= sc; a.y *= sc; }
                        *(LAS unsigned*)(img + row * 256 + (((lane >> 2) ^ swzf(row)) << 4) + (lane & 3) * 4) = pk2(a.x, a.y); }
                }
            }
            if (hx + 1 < (DBLP == 2 ? 2 * HC : HC)) fetch_raw((hx + 1) % HC);
            if (wave < 2) {
                const int d = wave, i = lane, row = d ? 63 - i : i; const float* sc = SCAL + (size_t)(m0 + row) * 32;
                const float beta = sigmoidf_(sc[d * 6 + h]);
                const float a = sc[12 + d * 6 + h];
                const float al = ((const float*)A->in[d ? 14 : 13])[l * 6 + h], db = ((const float*)A->in[d ? 16 : 15])[l * 6 + h];
                float g = -expf(al) * softplusf_(a + db) * 1.4426950408889634f;
#pragma unroll
                for (int o = 1; o < 64; o <<= 1) { const float t = shfl_up_f(g, o, lane); if (lane >= o) g += t; }
                const float glast = __builtin_bit_cast(float, __builtin_amdgcn_readlane(__builtin_bit_cast(int, g), 63));
                LAS float* tab = (LAS float*)(F.lds + NP_TAB) + d * 320;
                const float e2 = __builtin_amdgcn_exp2f(g);
                tab[i] = beta; tab[64 + i] = g; tab[128 + i] = e2; tab[192 + i] = beta * e2; tab[256 + i] = __builtin_amdgcn_exp2f(glast - g);
            }
            LBAR();
            RELAUNDER();
            const int d = wave >> 2, wj = wave & 3, r32 = lane & 31, hh = lane >> 5;
            const LAS float* tab = (const LAS float*)(F.lds + NP_TAB) + d * 320;
            LAS float* Ld = (LAS float*)(F.lds + NP_L) + d * (64 * LP);
            LAS unsigned char* Tp = F.lds + NP_T + d * 27648; LAS unsigned char* Tb = Tp + 9216; LAS unsigned char* Tbg = Tp + 18432;
            const int chain = (b * HC + h) * 2 + d, step = d ? 63 - chunk : chunk;
            const size_t inst = (size_t)chain * 64 + step;
            unsigned char* op = ws + WS_SCANOP + inst * SCANOP_BYTES;
#define FR(i) (d ? 63 - (i) : (i))
            {
                const int kk_mb = (wj == 0) ? 0 : 1, kk_nb = (wj == 1) ? 1 : 0, x_jb = (wj == 1) ? 1 : 0, x_ib = (wj == 0) ? 0 : 1;
                if (wj != 3) {
                    f32x16 acc;
#pragma unroll
                    for (int r = 0; r < 16; ++r) acc[r] = 0.f;
#pragma unroll
                    for (int s = 0; s < 8; ++s) acc = MFMA32(img_frag(kimg, FR(32 * kk_mb + r32), s, hh), img_frag(kimg, FR(32 * kk_nb + r32), s, hh), acc);
                    const int jc = 32 * kk_nb + r32; const float gj = tab[64 + jc];
#pragma unroll
                    for (int r = 0; r < 16; ++r) { const int i = 32 * kk_mb + crow(r, hh);
                        Ld[i * LP + jc] = (jc < i) ? acc[r] * tab[i] * __builtin_amdgcn_exp2f(tab[64 + i] - gj) : 0.f; }
                }
                if (wj != 2) {
                    f32x16 acc;
#pragma unroll
                    for (int r = 0; r < 16; ++r) acc[r] = 0.f;
#pragma unroll
                    for (int s = 0; s < 8; ++s) acc = MFMA32(img_frag(kimg, FR(32 * x_jb + r32), s, hh), img_frag(qimg, FR(32 * x_ib + r32), s, hh), acc);
                    const int i = 32 * x_ib + r32; const float gi = tab[64 + i];
#pragma unroll
                    for (int r = 0; r < 16; ++r) { const int jj = 32 * x_jb + crow(r, hh); acc[r] = (jj <= i) ? acc[r] * __builtin_amdgcn_exp2f(gi - tab[64 + jj]) : 0.f; }
#pragma unroll
                    for (int hf = 0; hf < 2; ++hf) *(bf16x8*)(op + SO_A + ((x_ib * 4 + 2 * x_jb + hf) * 64 + lane) * 16) = pack8(acc, hf);
                }
            }
            LBAR();
            RELAUNDER();
            if (wj == 0) {
                const int i0 = 32 * hh, c = r32; float sol[32];
                f32x4 cur[8], nxt[8];
#pragma unroll
                for (int j4 = 0; j4 < 8; ++j4) { cur[j4] = (f32x4){0.f, 0.f, 0.f, 0.f}; nxt[j4] = cur[j4]; }
                sol[0] = (c == 0) ? 1.f : 0.f;
                cur[0] = *(const LAS f32x4*)(Ld + (i0 + 1) * LP + i0);
#pragma unroll
                for (int i = 1; i < 32; ++i) {
                    if (i + 1 < 32) {
#pragma unroll
                        for (int j4 = 0; j4 < (i + 4) / 4; ++j4) nxt[j4] = *(const LAS f32x4*)(Ld + (i0 + i + 1) * LP + i0 + 4 * j4);
                    }
                    float a0 = (i == c) ? 1.f : 0.f, a1 = 0.f, a2 = 0.f, a3 = 0.f;
#pragma unroll
                    for (int j4 = 0; j4 < (i + 3) / 4; ++j4) { const f32x4 lv = cur[j4];
                        if (4 * j4 + 0 < i) a0 -= lv.x * sol[4 * j4 + 0]; if (4 * j4 + 1 < i) a1 -= lv.y * sol[4 * j4 + 1];
                        if (4 * j4 + 2 < i) a2 -= lv.z * sol[4 * j4 + 2]; if (4 * j4 + 3 < i) a3 -= lv.w * sol[4 * j4 + 3]; }
                    float a = (a0 + a1) + (a2 + a3);
                    asm volatile("" : "+v"(a) :: "memory"); sol[i] = a;
#pragma unroll
                    for (int j4 = 0; j4 < 8; ++j4) cur[j4] = nxt[j4];
                }
                const float bc = tab[i0 + c], bgc = tab[192 + i0 + c];
#pragma unroll
                for (int i = 0; i < 32; ++i) { const int off = (i0 + i) * TP + (i0 + c) * 2;
                    *(LAS bf16*)(Tp + off) = (bf16)f2bf(sol[i]); *(LAS bf16*)(Tb + off) = (bf16)f2bf(sol[i] * bc); *(LAS bf16*)(Tbg + off) = (bf16)f2bf(sol[i] * bgc);
                    if (hh == 1) { const int zo = i * TP + (32 + c) * 2; *(LAS bf16*)(Tb + zo) = 0; *(LAS bf16*)(Tbg + zo) = 0; } }
            } else {
#pragma unroll 1
                for (int f = wj - 1; f < 32; f += 3) {
                    if (f < 16) {
                        const int mb = f >> 3, s = f & 7, i = 32 * mb + r32, row = FR(i); const float eg = tab[128 + i];
                        const LAS unsigned char* rp = qimg + row * 256 + 8 * hh;
                        const u32x2 lo = *(const LAS u32x2*)(rp + (((2 * s) ^ swzf(row)) << 4)), hi = *(const LAS u32x2*)(rp + (((2 * s + 1) ^ swzf(row)) << 4));
                        u32x4 o; o.x = pk2(bflo(lo.x) * eg, bfhi(lo.x) * eg); o.y = pk2(bflo(lo.y) * eg, bfhi(lo.y) * eg); o.z = pk2(bflo(hi.x) * eg, bfhi(hi.x) * eg); o.w = pk2(bflo(hi.y) * eg, bfhi(hi.y) * eg);
                        *(u32x4*)(op + SO_Q + (f * 64 + lane) * 16) = o;
                    } else {
                        const int g = f - 16, a = g >> 2, s = g & 3;
                        const bf16x8 kf = img_frag_tr(kimg, s, a, lane, d);
                        const f32x4 d0 = *(const LAS f32x4*)(tab + 256 + 16 * s + 4 * hh), d1 = *(const LAS f32x4*)(tab + 256 + 16 * s + 8 + 4 * hh);
                        u32x4 o; o.x = pk2(bf2f((bf16)kf[0]) * d0.x, bf2f((bf16)kf[1]) * d0.y); o.y = pk2(bf2f((bf16)kf[2]) * d0.z, bf2f((bf16)kf[3]) * d0.w);
                        o.z = pk2(bf2f((bf16)kf[4]) * d1.x, bf2f((bf16)kf[5]) * d1.y); o.w = pk2(bf2f((bf16)kf[6]) * d1.z, bf2f((bf16)kf[7]) * d1.w);
                        *(u32x4*)(op + SO_K + (g * 64 + lane) * 16) = o;
                    }
                }
                if (wj == 1 && lane == 0) ((float*)(ws + WS_EW + 256 * 1024))[inst] = tab[128 + 63];
            }
            LBAR();
            RELAUNDER();
            if (wj == 0) {
                f32x16 P;
#pragma unroll
                for (int r = 0; r < 16; ++r) P[r] = 0.f;
#pragma unroll
                for (int s = 0; s < 2; ++s) {
                    const LAS float* lp = Ld + (32 + r32) * LP + 16 * s + 4 * hh; const f32x4 l0 = *(const LAS f32x4*)lp, l1 = *(const LAS f32x4*)(lp + 8);
                    u32x4 aw; aw.x = pk2(l0.x, l0.y); aw.y = pk2(l0.z, l0.w); aw.z = pk2(l1.x, l1.y); aw.w = pk2(l1.z, l1.w);
                    const int i16 = lane & 15, q_ = i16 >> 2, p = i16 & 3, blk = (lane >> 4) & 1;
                    const LAS unsigned char* tp = Tp + (16 * s + 4 * hh + q_) * TP + blk * 32 + p * 8;
                    const s16x4 lo = tr_read4(tp), hi = tr_read4(tp + 8 * TP);
                    P = MFMA32(__builtin_bit_cast(bf16x8, aw), ((bf16x8){lo[0], lo[1], lo[2], lo[3], hi[0], hi[1], hi[2], hi[3]}), P);
                }
                f32x16 T21;
#pragma unroll
                for (int r = 0; r < 16; ++r) T21[r] = 0.f;
#pragma unroll
                for (int s = 0; s < 2; ++s) {
                    const LAS unsigned char* tp = Tp + (32 + r32) * TP + (32 + 16 * s + 4 * hh) * 2;
                    const u32x2 lo = *(const LAS u32x2*)tp, hi = *(const LAS u32x2*)(tp + 16);
                    u32x4 aw; aw.x = lo.x; aw.y = lo.y; aw.z = hi.x; aw.w = hi.y;
                    T21 = MFMA32(__builtin_bit_cast(bf16x8, aw), pack8(P, s), T21);
                }
                const float bc = tab[r32], bgc = tab[192 + r32];
#pragma unroll
                for (int r = 0; r < 16; ++r) { const int off = (32 + crow(r, hh)) * TP + r32 * 2; const float v = -T21[r];
                    *(LAS bf16*)(Tb + off) = (bf16)f2bf(v * bc); *(LAS bf16*)(Tbg + off) = (bf16)f2bf(v * bgc); }
            }
            LBAR();
            RELAUNDER();
            {
                f32x16 au[2], aw[2];
#pragma unroll
                for (int mb = 0; mb < 2; ++mb)
#pragma unroll
                    for (int r = 0; r < 16; ++r) { au[mb][r] = 0.f; aw[mb][r] = 0.f; }
#pragma unroll
                for (int s = 0; s < 4; ++s) {
                    const bf16x8 vf = img_frag_tr(vimg, s, wj, lane, d), kf = img_frag_tr(kimg, s, wj, lane, d);
#pragma unroll
                    for (int mb = 0; mb < 2; ++mb) {
                        if (mb == 0 && s >= 2) continue;
                        const int to = (32 * mb + r32) * TP + (16 * s + 4 * hh) * 2;
                        const u32x2 b0 = *(const LAS u32x2*)(Tb + to), b1 = *(const LAS u32x2*)(Tb + to + 16), g0 = *(const LAS u32x2*)(Tbg + to), g1 = *(const LAS u32x2*)(Tbg + to + 16);
                        u32x4 tbw, tgw; tbw.x = b0.x; tbw.y = b0.y; tbw.z = b1.x; tbw.w = b1.y; tgw.x = g0.x; tgw.y = g0.y; tgw.z = g1.x; tgw.w = g1.y;
                        au[mb] = MFMA32(__builtin_bit_cast(bf16x8, tbw), vf, au[mb]);
                        aw[mb] = MFMA32(kf, __builtin_bit_cast(bf16x8, tgw), aw[mb]);
                    }
                }
#pragma unroll
                for (int mb = 0; mb < 2; ++mb) {
                    u32x4 o0, o1; o0.x = pk2(au[mb][0], au[mb][1]); o0.y = pk2(au[mb][2], au[mb][3]); o0.z = pk2(au[mb][4], au[mb][5]); o0.w = pk2(au[mb][6], au[mb][7]);
                    o1.x = pk2(au[mb][8], au[mb][9]); o1.y = pk2(au[mb][10], au[mb][11]); o1.z = pk2(au[mb][12], au[mb][13]); o1.w = pk2(au[mb][14], au[mb][15]);
                    u32x4* up = (u32x4*)(op + SO_U + ((wj * 2 + mb) * 64 + lane) * 32); up[0] = o0; up[1] = o1;
#pragma unroll
                    for (int r = 0; r < 16; ++r) aw[mb][r] = -aw[mb][r];
#pragma unroll
                    for (int hf = 0; hf < 2; ++hf) *(bf16x8*)(op + SO_W + ((mb * 8 + 2 * wj + hf) * 64 + lane) * 16) = pack8(aw[mb], hf);
                }
            }
#undef FR
        }
#endif
        __syncthreads();
    }
#undef RELAUNDER
}

constexpr int SC_GE = 2 * SCANOP_BYTES;
static_assert(SC_GE + 64 <= MISC_OFF, "scan lds");
__device__ __forceinline__ void scan_chain_wg(const Frame& F, int chain) {
    unsigned char* ws = F.ws; const int lane = F.lane, wave = F.wave;
    const int b = chain / 12, h = (chain >> 1) % 6, d = chain & 1;
    const unsigned char* op0 = ws + WS_SCANOP + (size_t)chain * 64 * SCANOP_BYTES;
    const float* GE = (const float*)(ws + WS_EW + 256 * 1024) + chain * 64;
    float* O = (float*)(ws + (d ? WS_OB : WS_OF));
    const int r32 = lane & 31, hh = lane >> 5;
    LAS unsigned char* lds = F.lds;
    const bool loader = wave >= 4;
    auto fill = [&](int step, int buf) {
        const unsigned char* src = op0 + (size_t)step * SCANOP_BYTES + (wave - 4) * 1024 + lane * 16;
        asm volatile("" : "+v"(src));
#pragma unroll
        for (int k = 0; k < 18; ++k) { const int pi = (wave - 4) + 4 * k;
            __builtin_amdgcn_global_load_lds((const unsigned*)(src + k * 4096), (LAS unsigned*)(lds + buf * SCANOP_BYTES + pi * 1024), 16, 0, 0); }
        if (wave == 4 && lane == 0) *(LAS float*)(lds + SC_GE + 4 * buf) = GE[step];
    };
    f32x16 S[4];
#pragma unroll
    for (int a = 0; a < 4; ++a)
#pragma unroll
        for (int r = 0; r < 16; ++r) S[a][r] = 0.f;
    if (loader) fill(0, 0);
    asm volatile("s_waitcnt vmcnt(0) lgkmcnt(0)" ::: "memory"); __builtin_amdgcn_s_barrier(); asm volatile("" ::: "memory");
    for (int step = 0; step < 64; ++step) {
        const int buf = step & 1;
        if (loader) {
            if (step + 1 < 64) fill(step + 1, buf ^ 1);
            asm volatile("s_waitcnt vmcnt(0) lgkmcnt(0)" ::: "memory");
        } else {
            const int slice = wave;
            const int chunk = d ? 63 - step : step;
            const LAS unsigned char* op = lds + buf * SCANOP_BYTES + lane * 16;
            const float ge = *(const LAS float*)(lds + SC_GE + 4 * buf);
            bf16x8 Sb[8];
#pragma unroll
            for (int a = 0; a < 4; ++a) { Sb[2 * a] = pack8(S[a], 0); Sb[2 * a + 1] = pack8(S[a], 1); }
            f32x16 vn[2];
#pragma unroll
            for (int mb = 0; mb < 2; ++mb) {
                const LAS u32x4* up = (const LAS u32x4*)(lds + buf * SCANOP_BYTES + SO_U + ((slice * 2 + mb) * 64 + lane) * 32);
                const u32x4 u0 = up[0], u1 = up[1];
                vn[mb][0] = bflo(u0.x); vn[mb][1] = bfhi(u0.x); vn[mb][2] = bflo(u0.y); vn[mb][3] = bfhi(u0.y); vn[mb][4] = bflo(u0.z); vn[mb][5] = bfhi(u0.z); vn[mb][6] = bflo(u0.w); vn[mb][7] = bfhi(u0.w);
                vn[mb][8] = bflo(u1.x); vn[mb][9] = bfhi(u1.x); vn[mb][10] = bflo(u1.y); vn[mb][11] = bfhi(u1.y); vn[mb][12] = bflo(u1.z); vn[mb][13] = bfhi(u1.z); vn[mb][14] = bflo(u1.w); vn[mb][15] = bfhi(u1.w);
            }
#pragma unroll
            for (int s = 0; s < 8; ++s)
#pragma unroll
                for (int mb = 0; mb < 2; ++mb) vn[mb] = MFMA32(*(const LAS bf16x8*)(op + SO_W + (mb * 8 + s) * 1024), Sb[s], vn[mb]);
            asm volatile("" ::: "memory"); __builtin_amdgcn_sched_barrier(0);
            bf16x8 Vb[4];
#pragma unroll
            for (int mb = 0; mb < 2; ++mb) { Vb[2 * mb] = pack8(vn[mb], 0); Vb[2 * mb + 1] = pack8(vn[mb], 1); }
#pragma unroll
            for (int a = 0; a < 4; ++a) {
#pragma unroll
                for (int r = 0; r < 16; ++r) S[a][r] *= ge;
            }
#pragma unroll
            for (int s = 0; s < 4; ++s)
#pragma unroll
                for (int a = 0; a < 4; ++a) S[a] = MFMA32(*(const LAS bf16x8*)(op + SO_K + (a * 4 + s) * 1024), Vb[s], S[a]);
            asm volatile("" ::: "memory"); __builtin_amdgcn_sched_barrier(0);
            f32x16 o[2];
#pragma unroll
            for (int mb = 0; mb < 2; ++mb)
#pragma unroll
                for (int r = 0; r < 16; ++r) o[mb][r] = 0.f;
#pragma unroll
            for (int s = 0; s < 8; ++s)
#pragma unroll
                for (int mb = 0; mb < 2; ++mb) o[mb] = MFMA32(*(const LAS bf16x8*)(op + SO_Q + (mb * 8 + s) * 1024), Sb[s], o[mb]);
            asm volatile("" ::: "memory"); __builtin_amdgcn_sched_barrier(0);
#pragma unroll
            for (int mb = 0; mb < 2; ++mb)
#pragma unroll
                for (int s = 0; s < 2 * (mb + 1); ++s) o[mb] = MFMA32(*(const LAS bf16x8*)(op + SO_A + (mb * 4 + s) * 1024), Vb[s], o[mb]);
            float* Ou = O + (size_t)(b * SEQ + chunk * 64) * WC + h * 128 + 32 * slice;
            const int voff = (d ? 4 - 4 * hh : 4 * hh) * WC + r32;
#pragma unroll
            for (int mb = 0; mb < 2; ++mb)
#pragma unroll
                for (int r = 0; r < 16; ++r) { const int ri = 32 * mb + (r & 3) + 8 * (r >> 2); float* rowp = Ou + (d ? 59 - ri : ri) * WC; rowp[voff] = o[mb][r]; }
            asm volatile("s_waitcnt lgkmcnt(0)" ::: "memory");
        }
        asm volatile("" ::: "memory"); __builtin_amdgcn_s_barrier(); asm volatile("" ::: "memory");
    }
}

__device__ __forceinline__ void glds16(const void* gsrc, unsigned lds_dst) { unsigned keep;
    asm volatile("s_mov_b32 %0, m0\n\ts_mov_b32 m0, %2\n\ts_nop 0\n\tglobal_load_lds_dwordx4 %1, off\n\ts_mov_b32 m0, %0" : "=&s"(keep) : "v"(gsrc), "s"(lds_dst) : "memory"); }
constexpr int AL_K = 0, AL_V = 18432, AL_BUF = 34816, AL_OST = 0, AL_LST = 65536, AL_LTAB = 66048;
static_assert(3 * AL_BUF <= MISC_OFF && AL_LTAB + 512 <= 3 * AL_BUF, "attn lds");
__device__ __forceinline__ void attn_unit(const Frame& F, int b, int h, int qb, float lam, float negM2, const float* subln, float out_scale) {
    const int lane = F.lane, wave = F.wave, qg = wave & 3, c = wave >> 2, r32 = lane & 31, hh = lane >> 5;
    unsigned char* ws = F.ws;
    const bf16* QKB = (const bf16*)(ws + WS_QKB);
    const bf16* PROJ = (const bf16*)(ws + WS_PROJ);
    bf16* MMIX = (bf16*)(ws + WS_MMIX);
    const size_t rowb = (size_t)b * SEQ;
    bf16x8 qf[4];
    { const bf16* Qrow = QKB + (rowb + qb * 128 + qg * 32 + r32) * 1536 + h * 128 + c * 64;
#pragma unroll
      for (int s = 0; s < 4; ++s) qf[s] = *(const bf16x8*)(Qrow + 16 * s + 8 * hh);
      asm volatile("" :: "v"(qf[0]), "v"(qf[1]), "v"(qf[2]), "v"(qf[3])); }
    f32x16 O[4];
#pragma unroll
    for (int db = 0; db < 4; ++db)
#pragma unroll
        for (int r = 0; r < 16; ++r) O[db][r] = 0.f;
    float lsum = 0.f;
    unsigned doff[5];
#pragma unroll
    for (int k = 0; k < 5; ++k) { int pi = wave + 8 * k; if (pi >= 34) pi -= 8;
        const int p = pi * 64 + lane; unsigned o = 0u;
        if (pi < 18) { const int cc = p / 576, q = p % 576, row = q / 9; int ch = q % 9; ch = ch > 7 ? 7 : ch; o = (unsigned)((row * 1536 + cc * 64 + 8 * ch) * 2); }
        else { const int pp = p - 1152, db = pp >> 8, row = (pp >> 2) & 63, c4 = pp & 3; o = (unsigned)((row * NPROJ + 32 * db + 8 * c4) * 2); }
        doff[k] = o; }
    const char* kbase = (const char*)(QKB + rowb * 1536 + 768 + h * 128);
    const char* vbase = (const char*)(PROJ + rowb * NPROJ + PC_VB + h * 128);
    const unsigned lds0 = (unsigned)(uintptr_t)F.lds;
    auto dma = [&](int T, int buf) {
        const char* kb = kbase + (size_t)T * (64 * 1536 * 2); const char* vb = vbase + (size_t)T * (64 * NPROJ * 2);
#pragma unroll
        for (int k = 0; k < 5; ++k) { int pi = wave + 8 * k; if (pi >= 34) pi -= 8;
            glds16((pi < 18 ? kb : vb) + doff[k], (unsigned)__builtin_amdgcn_readfirstlane((int)(lds0 + buf * AL_BUF + pi * 1024))); } };
    dma(0, 0); dma(1, 1);
    const int vlane = ((lane >> 4) & 1) * 32 + (lane & 3) * 8 + (4 * hh + ((lane & 15) >> 2)) * 64;
    int bcur = 0, bnxt2 = 2;
    for (int T = 0; T < 64; ++T) {
        if (T + 1 < 64) asm volatile("s_waitcnt vmcnt(5)" ::: "memory"); else asm volatile("s_waitcnt vmcnt(0)" ::: "memory");
        asm volatile("s_waitcnt lgkmcnt(0)" ::: "memory"); __builtin_amdgcn_s_barrier(); asm volatile("" ::: "memory");
        if (T + 2 < 64) dma(T + 2, bnxt2);
        const LAS unsigned char* lbuf = F.lds + bcur * AL_BUF;
        bcur = (bcur == 2) ? 0 : bcur + 1; bnxt2 = (bnxt2 == 2) ? 0 : bnxt2 + 1;
        const unsigned ka = (unsigned)(uintptr_t)(lbuf + AL_K + c * 9216) + (unsigned)(r32 * 144 + 16 * hh);
        const unsigned va = (unsigned)(uintptr_t)(lbuf + AL_V) + (unsigned)vlane;
#define KRD(dst, off) asm volatile("ds_read_b128 %0, %1 offset:%c2" : "=&v"(dst) : "v"(ka), "i"(off) : "memory")
#define VRD(dst, off) asm volatile("ds_read_b64_tr_b16 %0, %1 offset:%c2" : "=&v"(dst) : "v"(va), "i"(off) : "memory")
#define VGRP(L, H, db_) do { VRD(L[0], (db_) * 4096); VRD(H[0], (db_) * 4096 + 512); VRD(L[1], (db_) * 4096 + 1024); VRD(H[1], (db_) * 4096 + 1536); \
            VRD(L[2], (db_) * 4096 + 2048); VRD(H[2], (db_) * 4096 + 2560); VRD(L[3], (db_) * 4096 + 3072); VRD(H[3], (db_) * 4096 + 3584); } while (0)
#define VWAIT(N, L, H) asm volatile("s_waitcnt lgkmcnt(" #N ")" : "+v"(L[0]), "+v"(H[0]), "+v"(L[1]), "+v"(H[1]), "+v"(L[2]), "+v"(H[2]), "+v"(L[3]), "+v"(H[3]) :: "memory")
#define VFR(L, H, s_) ((bf16x8){L[s_][0], L[s_][1], L[s_][2], L[s_][3], H[s_][0], H[s_][1], H[s_][2], H[s_][3]})
        bf16x8 kf[8];
        KRD(kf[0], 0); KRD(kf[1], 32); KRD(kf[2], 64); KRD(kf[3], 96); KRD(kf[4], 4608); KRD(kf[5], 4640); KRD(kf[6], 4672); KRD(kf[7], 4704);
        asm volatile("s_waitcnt lgkmcnt(4)" : "+v"(kf[0]), "+v"(kf[1]), "+v"(kf[2]), "+v"(kf[3]) :: "memory");
        f32x16 s0, s1;
#pragma unroll
        for (int r = 0; r < 16; ++r) { s0[r] = negM2; s1[r] = negM2; }
#pragma unroll
        for (int s = 0; s < 4; ++s) s0 = MFMA32(kf[s], qf[s], s0);
        asm volatile("s_waitcnt lgkmcnt(0)" : "+v"(kf[4]), "+v"(kf[5]), "+v"(kf[6]), "+v"(kf[7]) :: "memory");
#pragma unroll
        for (int s = 0; s < 4; ++s) s1 = MFMA32(kf[4 + s], qf[s], s1);
        s16x4 vl0[4], vh0[4], vl1[4], vh1[4];
        VGRP(vl0, vh0, 0);
        bf16x8 pf[4];
        { float ls = 0.f;
#pragma unroll
          for (int r = 0; r < 16; ++r) { s0[r] = __builtin_amdgcn_exp2f(s0[r]); ls += s0[r]; }
          pf[0] = pack8(s0, 0); pf[1] = pack8(s0, 1);
#pragma unroll
          for (int r = 0; r < 16; ++r) { s1[r] = __builtin_amdgcn_exp2f(s1[r]); ls += s1[r]; }
          pf[2] = pack8(s1, 0); pf[3] = pack8(s1, 1);
          lsum += ls; }
        VGRP(vl1, vh1, 1);
        VWAIT(8, vl0, vh0);
#pragma unroll
        for (int s = 0; s < 4; ++s) O[0] = MFMA32(pf[s], VFR(vl0, vh0, s), O[0]);
        s16x4 vl2[4], vh2[4];
        VGRP(vl2, vh2, 2);
        VWAIT(8, vl1, vh1);
#pragma unroll
        for (int s = 0; s < 4; ++s) O[1] = MFMA32(pf[s], VFR(vl1, vh1, s), O[1]);
        s16x4 vl3[4], vh3[4];
        VGRP(vl3, vh3, 3);
        VWAIT(8, vl2, vh2);
#pragma unroll
        for (int s = 0; s < 4; ++s) O[2] = MFMA32(pf[s], VFR(vl2, vh2, s), O[2]);
        VWAIT(0, vl3, vh3);
#pragma unroll
        for (int s = 0; s < 4; ++s) O[3] = MFMA32(pf[s], VFR(vl3, vh3, s), O[3]);
#undef KRD
#undef VRD
#undef VGRP
#undef VWAIT
#undef VFR
    }
    lsum += shx<32>(lsum);
    LAS float* Ost = (LAS float*)(F.lds + AL_OST); LAS float* Lst = (LAS float*)(F.lds + AL_LST); LAS float* Ltab = (LAS float*)(F.lds + AL_LTAB);
    __syncthreads();
    if (c == 1) {
        if (hh == 0) Lst[qg * 32 + r32] = lsum;
#pragma unroll
        for (int db = 0; db < 4; ++db)
#pragma unroll
            for (int r = 0; r < 16; ++r) Ost[((qg * 4 + db) * 16 + r) * 64 + lane] = O[db][r];
    } else if (hh == 0) Ltab[qg * 32 + r32] = lsum;
    __syncthreads();
    if (c == 0) {
#pragma unroll
        for (int r = 0; r < 16; ++r) {
            const int q = crow(r, hh);
            const float i0 = 1.f / Ltab[qg * 32 + q], i1 = lam / Lst[qg * 32 + q];
            float ss = 0.f;
#pragma unroll
            for (int db = 0; db < 4; ++db) { const float v = O[db][r] * i0 - Ost[((qg * 4 + db) * 16 + r) * 64 + lane] * i1; O[db][r] = v; ss += v * v; }
            ss += shx<1>(ss); ss += shx<2>(ss); ss += shx<4>(ss); ss += shx<8>(ss); ss += shx<16>(ss);
            const float rstd = out_scale / sqrtf(ss * (1.f / 128.f) + EPS);
            bf16* orow = MMIX + (rowb + qb * 128 + qg * 32 + q) * D + WA + h * 128 + r32;
#pragma unroll
            for (int db = 0; db < 4; ++db) orow[32 * db] = (bf16)f2bf(O[db][r] * rstd * subln[32 * db + r32]);
        }
    }
    __syncthreads();
}

__device__ __forceinline__ void phase_delta_fin(const Frame& F, const float* o_norm) {
    const int gw = F.bid * 8 + F.wave, NGW = F.G * 8, lane = F.lane;
    const float* OF = (const float*)(F.ws + WS_OF); const float* OB = (const float*)(F.ws + WS_OB);
    const bf16* PROJ = (const bf16*)(F.ws + WS_PROJ); bf16* MMIX = (bf16*)(F.ws + WS_MMIX);
    const f32x2 gn = *(const f32x2*)(o_norm + 2 * lane);
    for (int m = 2 * gw; m < M; m += 2 * NGW) {
        f32x2 a[2][HC], c[2][HC]; unsigned g[2][HC];
#pragma unroll
        for (int r = 0; r < 2; ++r)
#pragma unroll
            for (int h = 0; h < HC; ++h) { a[r][h] = *(const f32x2*)(OF + (size_t)(m + r) * WC + h * 128 + 2 * lane); c[r][h] = *(const f32x2*)(OB + (size_t)(m + r) * WC + h * 128 + 2 * lane);
                g[r][h] = *(const unsigned*)(PROJ + (size_t)(m + r) * NPROJ + PC_GC + h * 128 + 2 * lane); }
#pragma unroll
        for (int r = 0; r < 2; ++r)
#pragma unroll
            for (int h = 0; h < HC; ++h) {
                const float o0 = a[r][h].x + c[r][h].x, o1 = a[r][h].y + c[r][h].y;
                const float rstd = 1.f / sqrtf(wave_sum(o0 * o0 + o1 * o1) * (1.f / 128.f) + EPS);
                *(unsigned*)(MMIX + (size_t)(m + r) * D + WA + WB + h * 128 + 2 * lane) = pk2(o0 * rstd * gn.x * siluf_(bflo(g[r][h])), o1 * rstd * gn.y * siluf_(bfhi(g[r][h])));
            }
    }
}

__device__ __forceinline__ void tile_of(int L, int nM, int nN, int& pm, int& pn) {
    const int nwg = nM * nN; int wgid = L; { const int q = nwg / 8, r = nwg % 8, xcd = wgid % 8, off = wgid / 8; wgid = (xcd < r ? xcd * (q + 1) : r * (q + 1) + (xcd - r) * q) + off; }
    const int nig = 8 * nN, gid = wgid / nig, fm = gid * 8, gsz = (nM - fm) < 8 ? (nM - fm) : 8;
    pm = fm + ((wgid % nig) % gsz); pn = (wgid % nig) / gsz;
}
struct SchedPlain {
    const char* A; const char* Bt; int lda, ldb, nM, nN, nt, G, c;
    __device__ __forceinline__ bool next(int i, pg8::Unit& u) const {
        const long L = (long)i * G + c; if (L >= (long)nM * nN) return false;
        int pm, pn; tile_of((int)L, nM, nN, pm, pn);
        u.a = A + (size_t)pm * 256 * lda * 2; u.b = Bt + (size_t)pn * 256 * ldb * 2; u.nt = nt; u.pm = pm; u.pn = pn; u.aux = 0; return true; }
    __device__ __forceinline__ int row_index(const pg8::Unit&, int) const { return 0; }
};
struct SchedOutProj {
    const char* A; const char* Bt; int G, c;
    __device__ __forceinline__ bool next(int i, pg8::Unit& u) const {
        const int ti = i / 3, br = i - 3 * ti; const long L = (long)ti * G + c; if (L >= 512) return false;
        int pm, pn; tile_of((int)L, 64, 8, pm, pn);
        const int koff = br == 0 ? 0 : (br == 1 ? 512 : 1280);
        u.a = A + ((size_t)pm * 256 * D + koff) * 2; u.b = Bt + ((size_t)pn * 256 * D + koff) * 2; u.nt = br == 0 ? 8 : 12; u.pm = pm; u.pn = pn; u.aux = br; return true; }
    __device__ __forceinline__ int row_index(const pg8::Unit&, int) const { return 0; }
};
struct SchedExpert {
    const char* A; const char* Bt; int lda, ldb, nt, G, c;
    __device__ __forceinline__ bool next(int i, pg8::Unit& u) const {
        const long L = (long)i * G + c; if (L >= 1024) return false;
        const int e = (int)L >> 6, rem = (int)L & 63, pm = rem & 7, pn = rem >> 3;
        const int row0 = ((pm >> 1) * 16 + e) * 512 + (pm & 1) * 256;
        u.a = A + (size_t)row0 * lda * 2; u.b = Bt + ((size_t)e * 2048 + pn * 256) * ldb * 2; u.nt = nt; u.pm = row0; u.pn = pn; u.aux = e; return true; }
    __device__ __forceinline__ int row_index(const pg8::Unit&, int) const { return 0; }
};
struct SchedExpertGather {
    const char* A; const char* Bt; const int* idx; int ldb, nt, G, c;
    __device__ __forceinline__ bool next(int i, pg8::Unit& u) const {
        const long L = (long)i * G + c; if (L >= 1024) return false;
        const int e = (int)L >> 6, rem = (int)L & 63, pm = rem & 7, pn = rem >> 3;
        const int row0 = ((pm >> 1) * 16 + e) * 512 + (pm & 1) * 256;
        u.a = A; u.b = Bt + ((size_t)e * 2048 + pn * 256) * ldb * 2; u.nt = nt; u.pm = row0; u.pn = pn; u.aux = e; return true; }
    __device__ __forceinline__ int row_index(const pg8::Unit& u, int r) const { return (u.pm >> 13) * SEQ + idx[u.pm + r]; }
};
typedef f32x4 acc_t[2][2][4][2];
struct EpiProj {
    static constexpr bool PERM = true;
    bf16* proj; float* scal; unsigned char* gates; const float* bias;
    __device__ __forceinline__ void operator()(const acc_t& acc, const pg8::Unit& u, int wr, int wc, int fr, int fq) const {
        const int row0 = u.pm * 256 + wr * 64 + fr;
        if (u.pn < 27) {
            const int col0 = u.pn * 256 + wc * 32 + 8 * fq;
#pragma unroll
            for (int ai = 0; ai < 2; ++ai)
#pragma unroll
                for (int m = 0; m < 4; ++m) { bf16* rowp = proj + (size_t)(row0 + ai * 128 + m * 16) * NPROJ + col0;
#pragma unroll
                    for (int bj = 0; bj < 2; ++bj) { const f32x4 v0 = acc[ai][bj][m][0], v1 = acc[ai][bj][m][1];
                        u32x4 w; w.x = pk2(v0[0], v0[1]); w.y = pk2(v0[2], v0[3]); w.z = pk2(v1[0], v1[1]); w.w = pk2(v1[2], v1[3]);
                        *(u32x4*)(rowp + bj * 128) = w; } }
        } else if (u.pn == 27) {
            if (wc == 0) {
            const int col0 = 8 * fq;
#pragma unroll
            for (int ai = 0; ai < 2; ++ai)
#pragma unroll
                for (int m = 0; m < 4; ++m) { float* rowp = scal + (size_t)(row0 + ai * 128 + m * 16) * 32 + col0;
                    *(f32x4*)rowp = acc[ai][0][m][0]; *(f32x4*)(rowp + 4) = acc[ai][0][m][1]; }
            }
        } else {
            const int col0 = (u.pn - 28) * 256 + wc * 32 + 8 * fq;
            f32x4 bv[2][2];
#pragma unroll
            for (int bj = 0; bj < 2; ++bj)
#pragma unroll
                for (int n = 0; n < 2; ++n) bv[bj][n] = *(const f32x4*)(bias + col0 + bj * 128 + 4 * n);
#pragma unroll
            for (int ai = 0; ai < 2; ++ai)
#pragma unroll
                for (int m = 0; m < 4; ++m) { unsigned char* rowp = gates + (size_t)(row0 + ai * 128 + m * 16) * NGATE + col0;
#pragma unroll
                    for (int bj = 0; bj < 2; ++bj) { const f32x4 v0 = acc[ai][bj][m][0] + bv[bj][0], v1 = acc[ai][bj][m][1] + bv[bj][1];
#define Q8(x) ((unsigned)__builtin_rintf(255.f * sigmoidf_(x)))
                        u32x2 w; w.x = Q8(v0[0]) | (Q8(v0[1]) << 8) | (Q8(v0[2]) << 16) | (Q8(v0[3]) << 24); w.y = Q8(v1[0]) | (Q8(v1[1]) << 8) | (Q8(v1[2]) << 16) | (Q8(v1[3]) << 24);
#undef Q8
                        *(u32x2*)(rowp + bj * 128) = w; } }
        }
    }
};
struct EpiGate {
    static constexpr bool PERM = true;
    bf16* gates; const float* bias;
    __device__ __forceinline__ void operator()(const acc_t& acc, const pg8::Unit& u, int wr, int wc, int fr, int fq) const {
        const int row0 = u.pm * 256 + wr * 64 + fr, col0 = u.pn * 256 + wc * 32 + 8 * fq;
        f32x4 bv[2][2];
#pragma unroll
        for (int bj = 0; bj < 2; ++bj)
#pragma unroll
            for (int n = 0; n < 2; ++n) bv[bj][n] = *(const f32x4*)(bias + col0 + bj * 128 + 4 * n);
#pragma unroll
        for (int ai = 0; ai < 2; ++ai)
#pragma unroll
            for (int m = 0; m < 4; ++m) { bf16* rowp = gates + (size_t)(row0 + ai * 128 + m * 16) * NGATE + col0;
#pragma unroll
                for (int bj = 0; bj < 2; ++bj) { const f32x4 v0 = acc[ai][bj][m][0] + bv[bj][0], v1 = acc[ai][bj][m][1] + bv[bj][1];
                    u32x4 w; w.x = pk2(sigmoidf_(v0[0]), sigmoidf_(v0[1])); w.y = pk2(sigmoidf_(v0[2]), sigmoidf_(v0[3])); w.z = pk2(sigmoidf_(v1[0]), sigmoidf_(v1[1])); w.w = pk2(sigmoidf_(v1[2]), sigmoidf_(v1[3]));
                    *(u32x4*)(rowp + bj * 128) = w; } }
    }
};
struct EpiOutProj {
    static constexpr bool PERM = true;
    const unsigned char* gates; float* zacc; bf16* z;
    __device__ __forceinline__ void operator()(const acc_t& acc, const pg8::Unit& u, int wr, int wc, int fr, int fq) const {
        const int br = u.aux, trow0 = wr * 64 + fr, tcol0 = wc * 32 + 8 * fq;
#pragma unroll
        for (int ai = 0; ai < 2; ++ai)
#pragma unroll
        for (int mh = 0; mh < 2; ++mh) {
            u32x2 g[2][2]; f32x4 zp0[2][2], zp1[2][2];
#pragma unroll
            for (int mm = 0; mm < 2; ++mm) { const int m = 2 * mh + mm; const int tr = trow0 + ai * 128 + m * 16; const size_t grow = (size_t)(u.pm * 256 + tr);
#pragma unroll
                for (int bj = 0; bj < 2; ++bj) { const int tc = tcol0 + bj * 128;
                    g[mm][bj] = *(const u32x2*)(gates + grow * NGATE + br * D + u.pn * 256 + tc);
                    if (br > 0) { const float* zp = zacc + tr * 256 + tc; zp0[mm][bj] = *(const f32x4*)zp; zp1[mm][bj] = *(const f32x4*)(zp + 4); } } }
#pragma unroll
            for (int mm = 0; mm < 2; ++mm) { const int m = 2 * mh + mm; const int tr = trow0 + ai * 128 + m * 16; const size_t grow = (size_t)(u.pm * 256 + tr);
#pragma unroll
                for (int bj = 0; bj < 2; ++bj) { const int tc = tcol0 + bj * 128; const u32x2 gg = g[mm][bj]; const float q = 1.f / 255.f;
                    f32x4 v0 = acc[ai][bj][m][0], v1 = acc[ai][bj][m][1];
                    v0[0] *= q * (float)(gg.x & 255u); v0[1] *= q * (float)((gg.x >> 8) & 255u); v0[2] *= q * (float)((gg.x >> 16) & 255u); v0[3] *= q * (float)(gg.x >> 24);
                    v1[0] *= q * (float)(gg.y & 255u); v1[1] *= q * (float)((gg.y >> 8) & 255u); v1[2] *= q * (float)((gg.y >> 16) & 255u); v1[3] *= q * (float)(gg.y >> 24);
                    if (br > 0) { v0 += zp0[mm][bj]; v1 += zp1[mm][bj]; }
                    float* zp = zacc + tr * 256 + tc;
                    if (br < 2) { *(f32x4*)zp = v0; *(f32x4*)(zp + 4) = v1; }
                    else { u32x4 w; w.x = pk2(v0[0], v0[1]); w.y = pk2(v0[2], v0[3]); w.z = pk2(v1[0], v1[1]); w.w = pk2(v1[2], v1[3]);
                        *(u32x4*)(z + grow * D + u.pn * 256 + tc) = w; } } }
            asm volatile("" ::: "memory");
        }
    }
};
struct EpiResid {
    static constexpr bool PERM = false;
    const float* x; float* hout;
    __device__ __forceinline__ void operator()(const acc_t& acc, const pg8::Unit& u, int wr, int wc, int fr, int fq) const {
        const int row0 = u.pm * 256 + wr * 64 + fr, col0 = u.pn * 256 + wc * 32 + 4 * fq;
#pragma unroll
        for (int ai = 0; ai < 2; ++ai)
#pragma unroll
            for (int m = 0; m < 4; ++m) { const size_t off = (size_t)(row0 + ai * 128 + m * 16) * D + col0;
#pragma unroll
                for (int bj = 0; bj < 2; ++bj)
#pragma unroll
                    for (int n = 0; n < 2; ++n) { const f32x4 xv = *(const f32x4*)(x + off + bj * 128 + n * 16); *(f32x4*)(hout + off + bj * 128 + n * 16) = xv + acc[ai][bj][m][n]; } }
    }
};
struct EpiSwiglu {
    static constexpr bool PERM = true;
    bf16* hid;
    __device__ __forceinline__ void operator()(const acc_t& acc, const pg8::Unit& u, int wr, int wc, int fr, int fq) const {
        const int row0 = u.pm + wr * 64 + fr, col0 = u.pn * 128 + wc * 32 + 8 * fq;
#pragma unroll
        for (int ai = 0; ai < 2; ++ai)
#pragma unroll
            for (int m = 0; m < 4; ++m) { const f32x4 g0 = acc[ai][0][m][0], g1 = acc[ai][0][m][1], u0 = acc[ai][1][m][0], u1 = acc[ai][1][m][1];
                u32x4 w; w.x = pk2(siluf_(g0[0]) * u0[0], siluf_(g0[1]) * u0[1]); w.y = pk2(siluf_(g0[2]) * u0[2], siluf_(g0[3]) * u0[3]);
                w.z = pk2(siluf_(g1[0]) * u1[0], siluf_(g1[1]) * u1[1]); w.w = pk2(siluf_(g1[2]) * u1[2], siluf_(g1[3]) * u1[3]);
                *(u32x4*)(hid + (size_t)(row0 + ai * 128 + m * 16) * FF + col0) = w; }
    }
};
struct EpiDown {
    static constexpr bool PERM = true;
    bf16* y; const float* ew;
    __device__ __forceinline__ void operator()(const acc_t& acc, const pg8::Unit& u, int wr, int wc, int fr, int fq) const {
        const int row0 = u.pm + wr * 64 + fr, col0 = u.pn * 256 + wc * 32 + 8 * fq;
#pragma unroll
        for (int ai = 0; ai < 2; ++ai)
#pragma unroll
            for (int m = 0; m < 4; ++m) { const int row = row0 + ai * 128 + m * 16; const float wgt = ew[row]; bf16* rowp = y + (size_t)row * D + col0;
#pragma unroll
                for (int bj = 0; bj < 2; ++bj) { const f32x4 v0 = acc[ai][bj][m][0] * wgt, v1 = acc[ai][bj][m][1] * wgt;
                    u32x4 w; w.x = pk2(v0[0], v0[1]); w.y = pk2(v0[2], v0[3]); w.z = pk2(v1[0], v1[1]); w.w = pk2(v1[2], v1[3]);
                    *(u32x4*)(rowp + bj * 128) = w; } }
    }
};

__device__ __forceinline__ float reduce16(float (&p)[16], int lane) {
#define RS_STEP(M, N) { const bool up = (lane & (M)) != 0; _Pragma("unroll") for (int i = 0; i < (N) / 2; ++i) { const float keep = up ? p[(N) / 2 + i] : p[i], send = up ? p[i] : p[(N) / 2 + i]; p[i] = keep + shx<(M)>(send); } }
    RS_STEP(32, 16) RS_STEP(16, 8) RS_STEP(8, 4) RS_STEP(4, 2)
#undef RS_STEP
    float r = p[0]; r += shx<1>(r); r += shx<2>(r); return r;
}
__device__ __forceinline__ void phase_router(const Frame& F, const float* hbuf, const float* gain) {
    LAS float* wT = (LAS float*)F.lds;
    const float* wrt = (const float*)(F.ws + WS_WRT);
    for (int i = F.tid; i < NE * D / 4; i += 512) *(LAS f32x4*)(wT + 4 * i) = *(const f32x4*)(wrt + 4 * i);
    __syncthreads();
    const int gw = F.bid * 8 + F.wave, NGW = F.G * 8, lane = F.lane;
    float* AFF = (float*)(F.ws + WS_AFF); bf16* XN = (bf16*)(F.ws + WS_XN);
    const int myexp = ((lane >> 5) & 1) * 8 + ((lane >> 4) & 1) * 4 + ((lane >> 3) & 1) * 2 + ((lane >> 2) & 1);
    for (int m = 2 * gw; m < M; m += 2 * NGW) {
        const f32x4* gr = (const f32x4*)gain + lane;
        f32x4 v[2][8]; float s[2] = {0.f, 0.f};
#pragma unroll
        for (int r = 0; r < 2; ++r) { const f32x4* xr = (const f32x4*)(hbuf + (size_t)(m + r) * D) + lane;
#pragma unroll
            for (int j = 0; j < 8; ++j) { v[r][j] = xr[64 * j]; s[r] += (v[r][j].x * v[r][j].x + v[r][j].y * v[r][j].y) + (v[r][j].z * v[r][j].z + v[r][j].w * v[r][j].w); } }
        const float rstd0 = 1.f / sqrtf(wave_sum(s[0]) * (1.f / D) + EPS), rstd1 = 1.f / sqrtf(wave_sum(s[1]) * (1.f / D) + EPS);
#pragma unroll
        for (int j = 0; j < 8; ++j) { const f32x4 g = gr[64 * j]; v[0][j] = v[0][j] * rstd0 * g; v[1][j] = v[1][j] * rstd1 * g; }
#pragma unroll
        for (int r = 0; r < 2; ++r) { u32x2* o = (u32x2*)(XN + (size_t)(m + r) * D) + lane;
#pragma unroll
            for (int j = 0; j < 8; ++j) { u32x2 w; w.x = pk2(v[r][j].x, v[r][j].y); w.y = pk2(v[r][j].z, v[r][j].w); o[64 * j] = w; } }
        float p0[16], p1[16];
#pragma unroll
        for (int e = 0; e < NE; ++e) { float a0 = 0.f, a1 = 0.f;
#pragma unroll
            for (int j = 0; j < 8; ++j) { const f32x4 w = *(LAS f32x4*)(wT + e * D + 4 * (lane + 64 * j));
                a0 += (v[0][j].x * w.x + v[0][j].y * w.y) + (v[0][j].z * w.z + v[0][j].w * w.w); a1 += (v[1][j].x * w.x + v[1][j].y * w.y) + (v[1][j].z * w.z + v[1][j].w * w.w); }
            asm volatile("" : "+v"(a0), "+v"(a1) :: "memory"); p0[e] = a0; p1[e] = a1; }
        float lg[2] = {reduce16(p0, lane), reduce16(p1, lane)};
#pragma unroll
        for (int r = 0; r < 2; ++r) {
            float mx = lg[r]; mx = fmaxf(mx, shx<4>(mx)); mx = fmaxf(mx, shx<8>(mx)); mx = fmaxf(mx, shx<16>(mx)); mx = fmaxf(mx, shx<32>(mx));
            const float ex = expf(lg[r] - mx); float den = ex; den += shx<4>(den); den += shx<8>(den); den += shx<16>(den); den += shx<32>(den);
            if ((lane & 3) == 0) AFF[(size_t)(m + r) * NE + myexp] = ex / den;
        }
    }
    __syncthreads();
}

__device__ __forceinline__ int block_excl_scan(int v, LAS int* tmp, int tid, int lane, int wave, int& total) {
    int inc = v;
#pragma unroll
    for (int o = 1; o < 64; o <<= 1) { const int t = shfl_up_i(inc, o, lane); if (lane >= o) inc += t; }
    __syncthreads();
    if (lane == 63) tmp[wave] = inc;
    __syncthreads();
    int base = 0, tot = 0;
#pragma unroll
    for (int w = 0; w < 8; ++w) { const int t = tmp[w]; if (w < wave) base += t; tot += t; }
    total = tot;
    return base + inc - v;
}
__device__ __forceinline__ void phase_topk(const Frame& F) {
    LAS int* hist = (LAS int*)F.lds;
    LAS int* tmp = (LAS int*)(F.lds + 1024);
    LAS int* bc = (LAS int*)(F.lds + 1088);
    const float* AFF = (const float*)(F.ws + WS_AFF);
    int* SEL = (int*)(F.ws + WS_SEL); int* IDX = (int*)(F.ws + WS_IDX); float* EW = (float*)(F.ws + WS_EW);
    const int tid = F.tid, lane = F.lane, wave = F.wave;
    for (int u = F.bid; u < BATCH * NE; u += F.G) {
        const int b = u >> 4, e = u & 15;
        unsigned key[8];
#pragma unroll
        for (int i = 0; i < 8; ++i) key[i] = __builtin_bit_cast(unsigned, AFF[(size_t)(b * SEQ + 8 * tid + i) * NE + e]);
        unsigned prefix = 0u, mask = 0u; int need = CAP;
        for (int pass = 3; pass >= 0; --pass) {
            __syncthreads();
            if (tid < 256) hist[tid] = 0;
            __syncthreads();
#pragma unroll
            for (int i = 0; i < 8; ++i) if ((key[i] & mask) == prefix) (void)__hip_atomic_fetch_add(&hist[(key[i] >> (8 * pass)) & 255u], 1, __ATOMIC_RELAXED, __HIP_MEMORY_SCOPE_WORKGROUP);
            __syncthreads();
            {
                const int hv = (tid < 256) ? hist[255 - tid] : 0;
                int tot_; const int above = block_excl_scan(hv, tmp, tid, lane, wave, tot_);
                if (tid < 256 && above < need && above + hv >= need) { bc[0] = 255 - tid; bc[1] = need - above; }
            }
            __syncthreads();
            prefix |= (unsigned)bc[0] << (8 * pass); mask |= 0xffu << (8 * pass); need = bc[1];
        }
        const unsigned thr = prefix;
        int neq = 0;
#pragma unroll
        for (int i = 0; i < 8; ++i) neq += (key[i] == thr);
        int tot; int eqr = block_excl_scan(neq, tmp, tid, lane, wave, tot);
        int sel[8], nsel = 0;
#pragma unroll
        for (int i = 0; i < 8; ++i) { const bool eq = key[i] == thr; sel[i] = (key[i] > thr) || (eq && eqr < need); eqr += eq; nsel += sel[i]; }
        int slot = block_excl_scan(nsel, tmp, tid, lane, wave, tot);
#pragma unroll
        for (int i = 0; i < 8; ++i) { const int t = 8 * tid + i;
            if (sel[i]) { IDX[u * CAP + slot] = t; EW[u * CAP + slot] = __builtin_bit_cast(float, key[i]); SEL[(size_t)(b * SEQ + t) * NE + e] = slot; ++slot; }
            else SEL[(size_t)(b * SEQ + t) * NE + e] = -1; }
    }
    __syncthreads();
}
__device__ __forceinline__ void phase_gather(const Frame& F) {
    const int gw = F.bid * 8 + F.wave, NGW = F.G * 8, lane = F.lane;
    const int* IDX = (const int*)(F.ws + WS_IDX); const bf16* XN = (const bf16*)(F.ws + WS_XN); bf16* XS = (bf16*)(F.ws + WS_XS);
    for (int r = gw; r < BATCH * NE * CAP; r += NGW) {
        const int b = r >> 13, t = IDX[r];
        const u32x4* src = (const u32x4*)(XN + (size_t)(b * SEQ + t) * D) + lane; u32x4* dst = (u32x4*)(XS + (size_t)r * D) + lane;
#pragma unroll
        for (int j = 0; j < 4; ++j) dst[64 * j] = src[64 * j];
    }
}
__device__ __forceinline__ void phase_combine(const Frame& F, float* hbuf, const float* next_gain) {
    const int gw = F.bid * 8 + F.wave, NGW = F.G * 8, lane = F.lane;
    const int* SEL = (const int*)(F.ws + WS_SEL); const bf16* Y = (const bf16*)(F.ws + WS_YSLOT);
    for (int m = 2 * gw; m < M; m += 2 * NGW) {
        f32x4 v[2][8]; int mysel[2];
#pragma unroll
        for (int r = 0; r < 2; ++r) { const f32x4* xr = (const f32x4*)(hbuf + (size_t)(m + r) * D) + lane;
#pragma unroll
            for (int j = 0; j < 8; ++j) v[r][j] = xr[64 * j];
            mysel[r] = (lane < NE) ? SEL[(size_t)(m + r) * NE + lane] : -1; }
        const int b = m >> 12;
        unsigned mk0 = (unsigned)(__ballot(mysel[0] >= 0) & 0xffffull), mk1 = (unsigned)(__ballot(mysel[1] >= 0) & 0xffffull);
        while (mk0 | mk1) {
            const int e0 = mk0 ? __builtin_ctz(mk0) : -1, e1 = mk1 ? __builtin_ctz(mk1) : -1;
            u32x2 y0[8], y1[8];
            if (e0 >= 0) { const int sl = __builtin_amdgcn_readlane(mysel[0], e0); const u32x2* yr = (const u32x2*)(Y + (size_t)((b * NE + e0) * CAP + sl) * D) + lane;
#pragma unroll
                for (int j = 0; j < 8; ++j) y0[j] = yr[64 * j]; }
            if (e1 >= 0) { const int sl = __builtin_amdgcn_readlane(mysel[1], e1); const u32x2* yr = (const u32x2*)(Y + (size_t)((b * NE + e1) * CAP + sl) * D) + lane;
#pragma unroll
                for (int j = 0; j < 8; ++j) y1[j] = yr[64 * j]; }
            if (e0 >= 0) {
#pragma unroll
                for (int j = 0; j < 8; ++j) { v[0][j].x += bflo(y0[j].x); v[0][j].y += bfhi(y0[j].x); v[0][j].z += bflo(y0[j].y); v[0][j].w += bfhi(y0[j].y); }
                mk0 &= mk0 - 1; }
            if (e1 >= 0) {
#pragma unroll
                for (int j = 0; j < 8; ++j) { v[1][j].x += bflo(y1[j].x); v[1][j].y += bfhi(y1[j].x); v[1][j].z += bflo(y1[j].y); v[1][j].w += bfhi(y1[j].y); }
                mk1 &= mk1 - 1; }
        }
#pragma unroll
        for (int r = 0; r < 2; ++r) { f32x4* xr = (f32x4*)(hbuf + (size_t)(m + r) * D) + lane;
#pragma unroll
            for (int j = 0; j < 8; ++j) xr[64 * j] = v[r][j]; }
        if (next_gain) {
            const f32x4* gr = (const f32x4*)next_gain + lane;
#pragma unroll
            for (int r = 0; r < 2; ++r) {
                float s = 0.f;
#pragma unroll
                for (int j = 0; j < 8; ++j) s += (v[r][j].x * v[r][j].x + v[r][j].y * v[r][j].y) + (v[r][j].z * v[r][j].z + v[r][j].w * v[r][j].w);
                const float rstd = 1.f / sqrtf(wave_sum(s) * (1.f / D) + EPS);
                u32x2* o = (u32x2*)((bf16*)(F.ws + WS_XN) + (size_t)(m + r) * D) + lane;
#pragma unroll
                for (int j = 0; j < 8; ++j) { const f32x4 g = gr[64 * j]; u32x2 w; w.x = pk2(v[r][j].x * rstd * g.x, v[r][j].y * rstd * g.y); w.y = pk2(v[r][j].z * rstd * g.z, v[r][j].w * rstd * g.w); o[64 * j] = w; }
            }
        }
    }
}

constexpr int NPH = 14;
template <int PSEL>
__device__ __forceinline__ void layer_body(Frame& F, const ArgsP kp, const int l) {
#define SEAM(k) do { if (PSEL < 0) { ArgsP A_ = kp; asm volatile("" : "+s"(A_)); LAS unsigned char* l_ = F.lds; asm volatile("" : "+s"(l_)); int w_ = F.wave; asm volatile("" : "+s"(w_)); int t_; asm volatile("v_mbcnt_lo_u32_b32 %0, -1, 0\n\tv_mbcnt_hi_u32_b32 %0, -1, %0" : "=v"(t_)); t_ += w_ * 64; \
        XcdBarrier b_; b_.bar = (unsigned*)(A_->ws + WS_CTL) + CW_BAR; b_.x = xb_xcc_id(); b_.st = (volatile LAS unsigned*)(l_ + MISC_OFF) + 8; xcd_barrier(b_, t_); } } while (0)
#ifndef PH_MASK
#define PH_MASK 0x3fff
#endif
#define IN(p) (((PH_MASK >> (p)) & 1) && (PSEL < 0 || PSEL == (p)))
#define PHASE_BEGIN() ArgsP A = kp; asm volatile("" : "+s"(A)); unsigned char* ws = A->ws; F.ws = ws; F.ctl = (unsigned*)(ws + WS_CTL); \
        { LAS unsigned char* l_ = F.lds; asm volatile("" : "+s"(l_)); F.lds = l_; } \
        { int w_ = F.wave; asm volatile("" : "+s"(w_)); int ln_; asm volatile("v_mbcnt_lo_u32_b32 %0, -1, 0\n\tv_mbcnt_hi_u32_b32 %0, -1, %0" : "=v"(ln_)); F.wave = w_; F.lane = ln_; F.tid = w_ * 64 + ln_; } \
        { int b_ = F.bid, g_ = F.G; asm volatile("" : "+s"(b_), "+s"(g_)); F.bid = b_; F.G = g_; }
        if (l == 0) {
        if (IN(0)) { PHASE_BEGIN(); phase_convert(F, A, l); phase_rms_x(F, (const float*)A->in[0], (const float*)A->in[2]); __syncthreads(); }
        SEAM(0);
        if (DBL == 0) { { PHASE_BEGIN(); phase_convert(F, A, l); phase_rms_x(F, (const float*)A->in[0], (const float*)A->in[2]); __syncthreads(); } SEAM(0); }
        }
        for (int rep_ = 0; rep_ < (DBL == 1 ? 2 : 1); ++rep_) {
        if (rep_) SEAM(1);
        if (IN(1)) { PHASE_BEGIN();
            SchedPlain S{(const char*)(ws + WS_XN), (const char*)(ws + WS_W1T), D, D, 64, 52, 32, F.G, F.bid};
            EpiProj E{(bf16*)(ws + WS_PROJ), (float*)(ws + WS_SCAL), (unsigned char*)(ws + WS_GATES), (const float*)A->in[22] + (size_t)l * NGATE};
            pg8::gemm_phase(F.lds, F.tid, D, D, S, E);
        }
        }
        SEAM(1);
        if (IN(2)) { PHASE_BEGIN(); phase_prep(F, A, l); }
        SEAM(2);
        if (DBL == 2) { { PHASE_BEGIN(); phase_prep(F, A, l); } SEAM(2); }
        for (int rep3 = 0; rep3 < (DBL == 33 ? 2 : 1); ++rep3) {
        if (rep3) SEAM(3);
        if (IN(3)) {
            { PHASE_BEGIN();
#ifndef NO_SCAN
            if (F.bid < 48 && (rep3 == 0 || (DBL3MASK & 1))) scan_chain_wg(F, F.bid);
#endif
            __syncthreads(); }
            if (DBL == 31) { PHASE_BEGIN(); if (F.bid < 48) scan_chain_wg(F, F.bid); __syncthreads(); }
            if (DBL >= 30) SEAM(3);
            { PHASE_BEGIN();
              if (F.bid >= 192 && (rep3 == 0 || (DBL3MASK & 2))) for (;;) {
                volatile LAS unsigned* MQ = (volatile LAS unsigned*)(F.lds + MISC_OFF);
                if (F.tid == 0) MQ[0] = __hip_atomic_fetch_add(F.ctl + CW_Q + 64 * (4 + l + 8 * rep3), 1u, RLX_AGENT);
                __syncthreads();
                const int u = (int)MQ[0];
                __syncthreads();
                if (u >= N_CVT_UNITS) break;
                convert_expert_unit(F, A, l, u);
              } }
            for (int rep = 0; rep < (DBL == 32 ? 2 : 1); ++rep) {
            PHASE_BEGIN();
            const float* qn = (const float*)A->in[5] + l * 64; const float* kn = (const float*)A->in[6] + l * 64;
            const float* lq1 = (const float*)A->in[7] + l * 64; const float* lk1 = (const float*)A->in[8] + l * 64;
            const float* lq2 = (const float*)A->in[9] + l * 64; const float* lk2 = (const float*)A->in[10] + l * 64;
            float d1 = 0.f, d2 = 0.f, gq = 0.f, gk = 0.f;
            for (int i = 0; i < 64; ++i) { d1 += lq1[i] * lk1[i]; d2 += lq2[i] * lk2[i]; gq = fmaxf(gq, fabsf(qn[i])); gk = fmaxf(gk, fabsf(kn[i])); }
            const float lam_init = 0.8f - 0.6f * expf(-0.3f * (float)l);
            const float lam = expf(d1) - expf(d2) + lam_init;
            const float negM2 = -(8.f * gq * gk * 1.4426950408889634f);
            const float* subln = (const float*)A->in[11] + l * 128;
            if (rep3 == 0 || (DBL3MASK & 4)) {
              const int xq = (int)(xb_xcc_id() & 7u);
#pragma unroll 1
              for (int kq = 0; kq < 8; ++kq) {
                const int q = (xq + kq) & 7;
                for (;;) {
                    volatile LAS unsigned* MQ = (volatile LAS unsigned*)(F.lds + MISC_OFF);
                    if (F.tid == 0) MQ[0] = __hip_atomic_fetch_add(F.ctl + CW_Q + 64 * (32 + ((l * 2 + rep) * 2 + rep3) * 8 + q), 1u, RLX_AGENT);
                    __syncthreads();
                    const int u = (int)MQ[0];
                    __syncthreads();
                    if (u >= 3 * 32) break;
                    const int bh = q + 8 * (u >> 5), qb = u & 31;
#ifndef NO_ATTN
                    attn_unit(F, bh / HB, bh % HB, qb, lam, negM2, subln, 1.f - lam_init);
#endif
                }
              }
            }
            if (DBL == 32 && rep == 0) SEAM(3);
            }
            { PHASE_BEGIN();
              if (F.bid < 192 && (rep3 == 0 || (DBL3MASK & 2))) for (;;) {
                volatile LAS unsigned* MQ = (volatile LAS unsigned*)(F.lds + MISC_OFF);
                if (F.tid == 0) MQ[0] = __hip_atomic_fetch_add(F.ctl + CW_Q + 64 * (4 + l + 8 * rep3), 1u, RLX_AGENT);
                __syncthreads();
                const int u = (int)MQ[0];
                __syncthreads();
                if (u >= N_CVT_UNITS) break;
                convert_expert_unit(F, A, l, u);
              } }
        }
        }
        SEAM(3);
        if (IN(4)) { PHASE_BEGIN(); phase_delta_fin(F, (const float*)A->in[17] + l * 128); }
        SEAM(4);
        for (int rep_ = 0; rep_ < (DBL == 6 ? 2 : 1); ++rep_) {
        if (rep_) SEAM(6);
        if (IN(6)) { PHASE_BEGIN();
            SchedOutProj S{(const char*)(ws + WS_MMIX), (const char*)(ws + WS_WOUTT), F.G, F.bid};
            EpiOutProj E{(const unsigned char*)(ws + WS_GATES), (float*)(ws + WS_ZACC) + (size_t)F.bid * 65536, (bf16*)(ws + WS_Z)};
            pg8::gemm_phase(F.lds, F.tid, D, D, S, E);
        }
        }
        SEAM(6);
        if (IN(7)) { PHASE_BEGIN();
            SchedPlain S{(const char*)(ws + WS_Z), (const char*)(ws + WS_WOT), D, D, 64, 8, 32, F.G, F.bid};
            EpiResid E{(l == 0) ? (const float*)A->in[0] : (const float*)A->out, A->out};
            pg8::gemm_phase(F.lds, F.tid, D, D, S, E);
        }
        SEAM(7);
        if (IN(8)) { PHASE_BEGIN(); phase_router(F, A->out, (const float*)A->in[24] + (size_t)l * D); }
        SEAM(8);
        if (IN(9)) { PHASE_BEGIN(); phase_topk(F); }
        SEAM(9);
        for (int rep_ = 0; rep_ < (DBL == 11 ? 2 : 1); ++rep_) {
        if (rep_) SEAM(11);
        if (IN(11)) { PHASE_BEGIN();
            SchedExpertGather S{(const char*)(ws + WS_XN), (const char*)(ws + WS_WGU), (const int*)(ws + WS_IDX), D, 32, F.G, F.bid};
            EpiSwiglu E{(bf16*)(ws + WS_HID)};
            pg8::gemm_phase<EpiSwiglu, SchedExpertGather, true>(F.lds, F.tid, D, D, S, E);
        }
        }
        SEAM(11);
        for (int rep_ = 0; rep_ < (DBL == 12 ? 2 : 1); ++rep_) {
        if (rep_) SEAM(12);
        if (IN(12)) { PHASE_BEGIN();
            SchedExpert S{(const char*)(ws + WS_HID), (const char*)(ws + WS_WDN), FF, FF, 16, F.G, F.bid};
            EpiDown E{(bf16*)(ws + WS_YSLOT), (const float*)(ws + WS_EW)};
            pg8::gemm_phase(F.lds, F.tid, FF, FF, S, E);
        }
        }
        SEAM(12);
        if (IN(13)) { PHASE_BEGIN(); phase_combine(F, A->out, (l + 1 < DEPTH) ? (const float*)A->in[2] + (size_t)(l + 1) * D : nullptr); if (l + 1 < DEPTH) { __syncthreads(); phase_convert(F, A, l + 1); __syncthreads(); } }
        if (l + 1 < DEPTH) SEAM(13);
#undef IN
#undef SEAM
#undef PHASE_BEGIN
}
template <int PSEL>
__global__ void __launch_bounds__(512, 2) fwd_kernel(Args args_unused) {
    extern __shared__ __attribute__((aligned(16))) unsigned char lds_raw[];
    const ArgsP kp = (ArgsP)__builtin_amdgcn_kernarg_segment_ptr();
    Frame F;
    F.lds = (LAS unsigned char*)lds_raw; F.ws = kp->ws; F.ctl = (unsigned*)(kp->ws + WS_CTL);
    F.tid = threadIdx.x; F.lane = F.tid & 63; F.wave = __builtin_amdgcn_readfirstlane(F.tid >> 6); F.bid = blockIdx.x; F.G = gridDim.x;
    volatile LAS unsigned* MISC = (volatile LAS unsigned*)(F.lds + MISC_OFF);
    if (F.tid < 32) MISC[F.tid] = 0u;
    __syncthreads();
    if (PSEL < 0) (void)xcd_barrier_post(F.ctl + CW_BAR, MISC + 8, F.tid);
    if (PSEL < 0) { layer_body<PSEL>(F, kp, 0); layer_body<PSEL>(F, kp, 1); }
    else layer_body<PSEL>(F, kp, kp->ph_lo);
}

static hipError_t set_lds_attr() {
    hipError_t e = hipSuccess;
#if MK_ONE_LAUNCH
    e = hipFuncSetAttribute((const void*)fwd_kernel<-1>, hipFuncAttributeMaxDynamicSharedMemorySize, LDS_BYTES);
#else
#define SA(p) if (e == hipSuccess) e = hipFuncSetAttribute((const void*)fwd_kernel<p>, hipFuncAttributeMaxDynamicSharedMemorySize, LDS_BYTES);
    SA(0) SA(1) SA(2) SA(3) SA(4) SA(5) SA(6) SA(7) SA(8) SA(9) SA(10) SA(11) SA(12) SA(13)
#undef SA
#endif
    return e;
}
extern "C" void kernel_launch(void* const* d_in, const int* in_sizes, int n_in, void* d_out, int out_size, void* d_ws, size_t ws_size, hipStream_t stream) {
    static int grid = 0;
    if (grid == 0) {
        if (n_in != 29 || out_size != M * D || ws_size < WS_END) { fprintf(stderr, "kernel_launch: unexpected shapes: n_in %d out %d ws %zu (need %zu)\n", n_in, out_size, ws_size, (size_t)WS_END); grid = -1; return; }
        int dev = 0, cus = 0;
        if (hipGetDevice(&dev) != hipSuccess || hipDeviceGetAttribute(&cus, hipDeviceAttributeMultiprocessorCount, dev) != hipSuccess) { grid = -1; return; }
        if (set_lds_attr() != hipSuccess) { fprintf(stderr, "kernel_launch: hipFuncSetAttribute failed\n"); grid = -1; return; }
        (void)hipGetLastError();
        grid = cus < 256 ? cus : 256;
    }
    if (grid < 0) return;
    (void)hipMemsetAsync((char*)d_ws + WS_CTL, 0, CTL_ZERO_BYTES, stream);
    Args a{};
    for (int i = 0; i < 29; ++i) a.in[i] = d_in[i];
    a.out = (float*)d_out; a.ws = (unsigned char*)d_ws;
#if MK_ONE_LAUNCH
    a.ph_lo = 0; a.ph_hi = DEPTH;
    hipLaunchKernelGGL(fwd_kernel<-1>, dim3(grid), dim3(512), LDS_BYTES, stream, a);
#else
    for (int l = 0; l < DEPTH; ++l) { a.ph_lo = l; a.ph_hi = l + 1;
#define LP(p) hipLaunchKernelGGL(fwd_kernel<p>, dim3(grid), dim3(512), LDS_BYTES, stream, a);
        LP(0) LP(1) LP(2) LP(3) LP(4) LP(5) LP(6) LP(7) LP(8) LP(9) LP(10) LP(11) LP(12) LP(13)
#undef LP
    }
#endif
}
```

```cpp
#include <hip/hip_runtime.h>
#include <cstdio>
#include <cstdint>
#include <cmath>

#ifndef DBLP
#define DBLP 0
#endif
#ifndef DBL3MASK
#define DBL3MASK 7
#endif
#ifndef DBL
#define DBL -1
#endif
#ifndef MK_ONE_LAUNCH
#define MK_ONE_LAUNCH 1
#endif

#define LAS __attribute__((address_space(3)))
#define GAS __attribute__((address_space(1)))
typedef unsigned short bf16;
typedef short bf16x8 __attribute__((ext_vector_type(8)));
typedef short s16x4 __attribute__((ext_vector_type(4)));
typedef float f32x4 __attribute__((ext_vector_type(4)));
typedef float f32x2 __attribute__((ext_vector_type(2)));
typedef float f32x16 __attribute__((ext_vector_type(16)));
typedef unsigned u32x4 __attribute__((ext_vector_type(4)));
typedef unsigned u32x2 __attribute__((ext_vector_type(2)));
typedef __bf16 bf16x2_t __attribute__((ext_vector_type(2)));

constexpr int D = 2048, BATCH = 4, SEQ = 4096, M = BATCH * SEQ, DEPTH = 2;
constexpr int NIN = 6936, NPROJ = 6912, NGATE = 6144, NPROJ_PAD = 7168;
constexpr int WA = 512, WB = 768, WC = 768, HB = 6, HC = 6;
constexpr int NE = 16, CAP = 512, FF = 1024;
constexpr float EPS = 1e-6f;
constexpr int PC_BA = 0, PC_CA = 512, PC_VA = 1024, PC_QB = 1536, PC_KB = 2304, PC_VB = 3072, PC_QC = 3840, PC_KC = 4608, PC_VC = 5376, PC_GC = 6144;
constexpr int NCHUNK = SEQ / 64;

__device__ __forceinline__ unsigned f2bf(float f) { unsigned u = __builtin_bit_cast(unsigned, f); return (u + 0x7fffu + ((u >> 16) & 1u)) >> 16; }
__device__ __forceinline__ unsigned pk2(float lo, float hi) { f32x2 v = {lo, hi}; bf16x2_t b = __builtin_convertvector(v, bf16x2_t); return __builtin_bit_cast(unsigned, b); }
__device__ __forceinline__ float bf2f(unsigned short h) { return __builtin_bit_cast(float, (unsigned)h << 16); }
__device__ __forceinline__ float bflo(unsigned w) { return __builtin_bit_cast(float, w << 16); }
__device__ __forceinline__ float bfhi(unsigned w) { return __builtin_bit_cast(float, w & 0xffff0000u); }
__device__ __forceinline__ float sigmoidf_(float x) { return __builtin_amdgcn_rcpf(1.f + __builtin_amdgcn_exp2f(-1.4426950408889634f * x)); }
__device__ __forceinline__ float siluf_(float x) { return x * __builtin_amdgcn_rcpf(1.f + __builtin_amdgcn_exp2f(-1.4426950408889634f * x)); }
template <int O> __device__ __forceinline__ float shx(float v) {
    if constexpr (O < 32) return __builtin_bit_cast(float, __builtin_amdgcn_ds_swizzle(__builtin_bit_cast(int, v), (O << 10) | 0x1f));
    else { const unsigned u = __builtin_bit_cast(unsigned, v); auto rr = __builtin_amdgcn_permlane32_swap(u, u, false, false);
        const unsigned a = rr[0], b = rr[1]; return __builtin_bit_cast(float, a == u ? b : a); }
}
__device__ __forceinline__ float wave_sum(float v) {
    v += shx<1>(v); v += shx<2>(v); v += shx<4>(v); v += shx<8>(v); v += shx<16>(v);
    const unsigned u = __builtin_bit_cast(unsigned, v); auto rr = __builtin_amdgcn_permlane32_swap(u, u, false, false);
    return __builtin_bit_cast(float, (unsigned)rr[0]) + __builtin_bit_cast(float, (unsigned)rr[1]);
}
__device__ __forceinline__ float shfl_up_f(float v, int o, int lane) { return __builtin_bit_cast(float, __builtin_amdgcn_ds_bpermute(((lane - o) & 63) << 2, __builtin_bit_cast(int, v))); }
__device__ __forceinline__ int shfl_up_i(int v, int o, int lane) { return __builtin_amdgcn_ds_bpermute(((lane - o) & 63) << 2, v); }
#define LDS_WAIT() asm volatile("s_waitcnt lgkmcnt(0)" ::: "memory")
#define LBAR() do { asm volatile("s_waitcnt lgkmcnt(0)" ::: "memory"); __builtin_amdgcn_s_barrier(); asm volatile("" ::: "memory"); } while (0)
#define VM_WAIT() asm volatile("s_waitcnt vmcnt(0)" ::: "memory")

namespace pg8 {
constexpr int BM = 256, BK = 64, HALF = 128, HTB = HALF * BK * 2, STAGE_BYTES = 8 * HTB;
__host__ __device__ __forceinline__ int lds_byte(int r, int c) { const int st = (r >> 4) * 2 + (c >> 5), rr = r & 15, cc = c & 31, ob = rr * 64 + cc * 2; return st * 1024 + (ob ^ (((ob >> 9) & 1) << 5)); }
__host__ __device__ __forceinline__ void stage_rc(int b, int& R, int& C) { const int st = b / 1024, sb = b % 1024, swz = sb ^ (((sb >> 9) & 1) << 5); R = (st >> 1) * 16 + swz / 64; C = (st & 1) * 32 + (swz % 64) / 2; }
__host__ __device__ __forceinline__ int perm32(int rho) { const int n = rho >> 4, i = rho & 15; return 8 * (i >> 2) + 4 * n + (i & 3); }

struct Unit { const char* a; const char* b; int nt; int pm, pn, aux; };

template <class Epi, class Sched, bool GATHER = false>
__device__ __forceinline__ void gemm_phase(LAS unsigned char* lds, const int tid, const int lda, const int ldb, const Sched& S, const Epi& E) {
    const int wid = __builtin_amdgcn_readfirstlane(tid >> 6), lane = tid & 63, wr = wid >> 2, wc = wid & 3, fr = lane & 15, fq = lane >> 4;
    unsigned voffA[2], voffB[2];
#pragma unroll
    for (int i = 0; i < 2; ++i) { int R, C; stage_rc(tid * 16 + i * 8192, R, C); const int Rb = Epi::PERM ? ((R & ~31) + perm32(R & 31)) : R;
        voffA[i] = (unsigned)(R * lda + C) * 2u; voffB[i] = (unsigned)(Rb * ldb + C) * 2u; }
    const size_t kstep = (size_t)(BK * 2);
    const size_t hstepA = (size_t)HALF * lda * 2, hstepB = (size_t)HALF * ldb * 2;
    const unsigned ldsw = (unsigned)wid * 1024u;
    const int aoff = lds_byte(wr * 64 + fr, fq * 8), boff = lds_byte(wc * 32 + fr, fq * 8);
#define PG8_SA(b, h) (((b) * 2 + (h)) * HTB)
#define PG8_SB(b, h) ((4 + (b) * 2 + (h)) * HTB)
#define PG8_STAGE(bufoff, gbase, voff) do { _Pragma("unroll") for (int _i = 0; _i < 2; ++_i) \
        __builtin_amdgcn_global_load_lds((const unsigned*)((const char*)(gbase) + (voff)[_i]), (LAS unsigned*)(lds + (bufoff) + ldsw + _i * 8192), 16, 0, 0); } while (0)
#define PG8_LDA(dst, b, h) do { _Pragma("unroll") for (int m = 0; m < 4; ++m) _Pragma("unroll") for (int k = 0; k < 2; ++k) dst[m][k] = *(const LAS bf16x8*)(lds + PG8_SA(b, h) + aoff + m * 2048 + k * 1024); } while (0)
#define PG8_LDB(dst, b, h) do { _Pragma("unroll") for (int n = 0; n < 2; ++n) _Pragma("unroll") for (int k = 0; k < 2; ++k) dst[n][k] = *(const LAS bf16x8*)(lds + PG8_SB(b, h) + boff + n * 2048 + k * 1024); } while (0)
#define PG8_MMA(ai, bj, At, Bt) do { __builtin_amdgcn_s_setprio(1); _Pragma("unroll") for (int m = 0; m < 4; ++m) _Pragma("unroll") for (int n = 0; n < 2; ++n) _Pragma("unroll") for (int k = 0; k < 2; ++k) \
        acc[ai][bj][m][n] = __builtin_amdgcn_mfma_f32_16x16x32_bf16(Bt[n][k], At[m][k], acc[ai][bj][m][n], 0, 0, 0); __builtin_amdgcn_s_setprio(0); } while (0)
#define PG8_WAIT_V(n) asm volatile("s_waitcnt vmcnt(" #n ")" ::: "memory")
#define PG8_WAIT_L(n) asm volatile("s_waitcnt lgkmcnt(" #n ")" ::: "memory")
#define PG8_BAR __builtin_amdgcn_s_barrier()
#define PG8_SCHED __builtin_amdgcn_sched_barrier(0)
    Unit cur, nxt; int ui = 0;
    if (!S.next(0, cur)) return;
    f32x4 acc[2][2][4][2];
#pragma unroll
    for (int a = 0; a < 2; ++a)
#pragma unroll
        for (int b = 0; b < 2; ++b)
#pragma unroll
            for (int m = 0; m < 4; ++m)
#pragma unroll
                for (int n = 0; n < 2; ++n) acc[a][b][m][n] = (f32x4){0.f, 0.f, 0.f, 0.f};
    bf16x8 At[4][2], B0[2][2], B1[2][2];
    const char* cA = cur.a; const char* cB = cur.b;
    unsigned cv[2][2], nv[2][2];
#pragma unroll
    for (int i = 0; i < 2; ++i) { cv[0][i] = voffA[i]; cv[1][i] = voffA[i] + (unsigned)hstepA; nv[0][i] = cv[0][i]; nv[1][i] = cv[1][i]; }
    auto gather_offs = [&](const Unit& u, unsigned (&v)[2][2]) {
#pragma unroll
        for (int h = 0; h < 2; ++h)
#pragma unroll
            for (int i = 0; i < 2; ++i) { int R, C; stage_rc(tid * 16 + i * 8192, R, C); v[h][i] = (unsigned)(S.row_index(u, h * HALF + R) * lda + C) * 2u; } };
    if constexpr (GATHER) { gather_offs(cur, cv); }
    PG8_STAGE(PG8_SB(0, 0), cB, voffB); PG8_STAGE(PG8_SB(0, 1), cB + hstepB, voffB); PG8_STAGE(PG8_SA(0, 0), cA, cv[0]); PG8_STAGE(PG8_SA(0, 1), cA, cv[1]);
    if (wr == 1) PG8_BAR;
    PG8_WAIT_V(2); PG8_BAR;
    PG8_STAGE(PG8_SB(1, 0), cB + kstep, voffB); PG8_STAGE(PG8_SA(1, 0), cA + kstep, cv[0]); PG8_STAGE(PG8_SB(1, 1), cB + hstepB + kstep, voffB);
    PG8_WAIT_V(6); PG8_BAR;
    for (;;) {
        const bool has_next = S.next(ui + 1, nxt);
        const char* nA = has_next ? nxt.a : cA; const char* nB = has_next ? nxt.b : cB;
        if constexpr (GATHER) { if (has_next) gather_offs(nxt, nv); else {
#pragma unroll
            for (int h = 0; h < 2; ++h)
#pragma unroll
                for (int i = 0; i < 2; ++i) nv[h][i] = cv[h][i]; } }
        const int nt = cur.nt;
        for (int t = 0; t < nt; t += 2) {
            const bool last = (t == nt - 2);
            const char* a1 = cA + (size_t)(t + 1) * kstep;
            const char* a2 = last ? nA : cA + (size_t)(t + 2) * kstep; const char* b2 = last ? nB : cB + (size_t)(t + 2) * kstep;
            const char* a3 = a2 + kstep; const char* b3 = b2 + kstep;
            unsigned s0[2], s1[2];
#pragma unroll
            for (int i = 0; i < 2; ++i) { s0[i] = (GATHER && last) ? nv[0][i] : cv[0][i]; s1[i] = (GATHER && last) ? nv[1][i] : cv[1][i]; }
            PG8_LDB(B0, 0, 0); PG8_LDB(B1, 0, 1); PG8_SCHED; PG8_LDA(At, 0, 0); PG8_STAGE(PG8_SA(1, 1), a1, cv[1]);
            PG8_WAIT_V(8); PG8_WAIT_L(0); PG8_BAR; PG8_MMA(0, 0, At, B0); PG8_MMA(0, 1, At, B1); PG8_BAR; PG8_SCHED;
            PG8_LDA(At, 0, 1); PG8_STAGE(PG8_SB(0, 0), b2, voffB); PG8_STAGE(PG8_SB(0, 1), b2 + hstepB, voffB); PG8_STAGE(PG8_SA(0, 0), a2, s0);
            PG8_WAIT_V(8); PG8_WAIT_L(0); PG8_BAR; PG8_MMA(1, 0, At, B0); PG8_MMA(1, 1, At, B1); PG8_BAR; PG8_SCHED;
            PG8_LDB(B0, 1, 0); PG8_LDB(B1, 1, 1); PG8_SCHED; PG8_LDA(At, 1, 0); PG8_STAGE(PG8_SA(0, 1), a2, s1);
            PG8_WAIT_V(8); PG8_WAIT_L(0); PG8_BAR; PG8_MMA(0, 0, At, B0); PG8_MMA(0, 1, At, B1); PG8_BAR; PG8_SCHED;
            PG8_LDA(At, 1, 1); PG8_STAGE(PG8_SB(1, 0), b3, voffB); PG8_STAGE(PG8_SB(1, 1), b3 + hstepB, voffB); PG8_STAGE(PG8_SA(1, 0), a3, s0);
            PG8_WAIT_V(8); PG8_WAIT_L(0); PG8_BAR; PG8_MMA(1, 0, At, B0); PG8_MMA(1, 1, At, B1); PG8_BAR; PG8_SCHED;
        }
        if (wr == 0) PG8_BAR;
        E(acc, cur, wr, wc, fr, fq);
        if (!has_next) break;
        if (!(Epi::KEEPS && cur.aux < 2)) {
#pragma unroll
        for (int a = 0; a < 2; ++a)
#pragma unroll
            for (int b = 0; b < 2; ++b)
#pragma unroll
                for (int m = 0; m < 4; ++m)
#pragma unroll
                    for (int n = 0; n < 2; ++n) acc[a][b][m][n] = (f32x4){0.f, 0.f, 0.f, 0.f};
        }
        cur = nxt; cA = nA; cB = nB; ++ui;
        if constexpr (GATHER) {
#pragma unroll
            for (int h = 0; h < 2; ++h)
#pragma unroll
                for (int i = 0; i < 2; ++i) cv[h][i] = nv[h][i]; }
        if (wr == 1) PG8_BAR;
    }
    PG8_WAIT_V(0);
    PG8_BAR;
#undef PG8_SA
#undef PG8_SB
#undef PG8_STAGE
#undef PG8_LDA
#undef PG8_LDB
#undef PG8_MMA
#undef PG8_WAIT_V
#undef PG8_WAIT_L
#undef PG8_BAR
#undef PG8_SCHED
}
}

constexpr size_t MiB = 1u << 20;
constexpr size_t WS_CTL = 0, CTL_ZERO_BYTES = 1 * MiB;
constexpr size_t WS_W1T = 1 * MiB;
constexpr size_t WS_WGT = 29 * MiB;
constexpr size_t WS_WOUTT = 53 * MiB;
constexpr size_t WS_WOT = 61 * MiB;
constexpr size_t WS_WGU = 69 * MiB;
constexpr size_t WS_WDN = 197 * MiB;
constexpr size_t WS_WRT = 261 * MiB;
constexpr size_t WS_XN = 262 * MiB;
constexpr size_t WS_PROJ = 326 * MiB;
constexpr size_t WS_HID = WS_PROJ;
constexpr size_t WS_YSLOT = WS_PROJ + 64 * MiB;
constexpr size_t WS_SCAL = 542 * MiB;
constexpr size_t WS_MMIX = 544 * MiB;
constexpr size_t WS_QKB = 608 * MiB;
constexpr size_t WS_SCANOP = 656 * MiB;
constexpr size_t WS_Z = WS_SCANOP;
constexpr size_t WS_ZACC = WS_SCANOP + 64 * MiB;
constexpr size_t WS_XS = WS_SCANOP;
constexpr size_t WS_OF = 872 * MiB;
constexpr size_t WS_OB = 920 * MiB;
constexpr size_t WS_AFF = 968 * MiB;
constexpr size_t WS_SEL = 969 * MiB;
constexpr size_t WS_IDX = 970 * MiB;
constexpr size_t WS_EW = 970 * MiB + 512 * 1024;
constexpr size_t WS_GATES = 972 * MiB;
constexpr size_t WS_END = 1164 * MiB;
static_assert(WS_WGT == WS_W1T + (size_t)NPROJ_PAD * D * 2, "W_in^T and W_gate^T form one [13312][2048] B matrix");
constexpr int SCANOP_BYTES = 73728;
constexpr int SO_W = 0, SO_Q = 16384, SO_K = 32768, SO_A = 49152, SO_U = 57344;
constexpr int CW_TMO = 0, CW_BAR = 4096, CW_Q = 8192;

constexpr int LDS_BYTES = 163840, MISC_OFF = 163584;
static_assert(pg8::STAGE_BYTES <= MISC_OFF, "lds");

#define RLX_AGENT __ATOMIC_RELAXED, __HIP_MEMORY_SCOPE_AGENT
#define XB_TMO      128
#define XB_XCNT(j)  (256  + 64 * (j))
#define XB_XSUB(j)  (1280 + 64 * (j))
#define XB_XGEN(j)  (2304 + 64 * (j))
#define XB_TOP      3328
#define XB_TOPGEN   3392
#define XCD_BAR_WORDS 3456
#define XB_SPIN_CAP (1u << 18)
__device__ __forceinline__ unsigned xb_ld(unsigned* p)              { return __hip_atomic_load(p, __ATOMIC_RELAXED, __HIP_MEMORY_SCOPE_AGENT); }
__device__ __forceinline__ unsigned xb_add(unsigned* p, unsigned v) { return __hip_atomic_fetch_add(p, v, __ATOMIC_RELAXED, __HIP_MEMORY_SCOPE_AGENT); }
__device__ __forceinline__ unsigned xb_xcc_id() { return (unsigned)__builtin_amdgcn_s_getreg((3 << 11) | 20) & 0xFu; }
#define XB_SPIN(cond, bar) do { unsigned _sp = 0; while (cond) { __builtin_amdgcn_s_sleep(1); \
    if ((++_sp & 255u) == 0u) { if (xb_ld(&(bar)[XB_TMO])) break; if (_sp > XB_SPIN_CAP) { atomicAdd(&(bar)[XB_TMO], 1u); break; } } } } while (0)
struct XcdBarrier { unsigned* bar; unsigned x; volatile LAS unsigned* st; };
__device__ __forceinline__ XcdBarrier xcd_barrier_post(unsigned* bar, volatile LAS unsigned* st, int tid) {
    XcdBarrier b; b.bar = bar; b.x = xb_xcc_id(); b.st = st;
    if (tid == 0) (void)xb_add(&bar[XB_XCNT(b.x)], 1u);
    return b;
}
__device__ __forceinline__ void xcd_barrier_complete(unsigned* bar, unsigned x, unsigned& nloc, unsigned& nx) {
    const unsigned G = gridDim.x * gridDim.y * gridDim.z;
    unsigned sum, cnt, mine, sp = 0u;
    for (;;) {
        sum = 0u; cnt = 0u; mine = 0u;
#pragma unroll 1
        for (unsigned j = 0; j < 16; ++j) { const unsigned c = xb_ld(&bar[XB_XCNT(j)]); sum += c; cnt += (c > 0u) ? 1u : 0u; mine = (j == x) ? c : mine; }
        if (sum == G) break;
        __builtin_amdgcn_s_sleep(1);
        if ((++sp & 255u) == 0u) { if (xb_ld(&bar[XB_TMO])) break; if (sp > XB_SPIN_CAP) { atomicAdd(&bar[XB_TMO], 1u); break; } }
    }
    nloc = mine > 0u ? mine : 1u; nx = cnt > 0u ? cnt : 1u;
}
__device__ __forceinline__ void xcd_barrier(const XcdBarrier& b, int tid) {
    asm volatile("s_waitcnt vmcnt(0)" ::: "memory");
    __syncthreads();
    if (tid == 0) {
        unsigned* bar = b.bar;
        __builtin_amdgcn_s_waitcnt(0);
        unsigned nloc = b.st[0], nx = b.st[1];
        if (nloc == 0u) { xcd_barrier_complete(bar, b.x, nloc, nx); b.st[0] = nloc; b.st[1] = nx; }
        const unsigned old = xb_add(&bar[XB_XSUB(b.x)], 1u);
        const unsigned gen = old / nloc;
        if (old + 1u == (gen + 1u) * nloc) {
            __builtin_amdgcn_fence(__ATOMIC_RELEASE, "agent");
            asm volatile("s_waitcnt vmcnt(0)" ::: "memory");
            const unsigned og = xb_add(&bar[XB_TOP], 1u);
            const unsigned tg = og / nx;
            if (og + 1u == (tg + 1u) * nx) xb_add(&bar[XB_TOPGEN], 1u);
            else XB_SPIN(xb_ld(&bar[XB_TOPGEN]) == tg, bar);
            __builtin_amdgcn_fence(__ATOMIC_ACQUIRE, "agent");
            xb_add(&bar[XB_XGEN(b.x)], 1u);
            asm volatile("s_waitcnt vmcnt(0)" ::: "memory");
        } else {
            XB_SPIN(xb_ld(&bar[XB_XGEN(b.x)]) == gen, bar);
            __builtin_amdgcn_fence(__ATOMIC_ACQUIRE, "agent");
            asm volatile("s_waitcnt vmcnt(0)" ::: "memory");
        }
    }
    __syncthreads();
}

struct Args { const void* in[29]; float* out; unsigned char* ws; int ph_lo, ph_hi; };
typedef const Args __attribute__((address_space(4)))* ArgsP;
struct Frame {
    LAS unsigned char* lds;
    unsigned char* ws;
    unsigned* ctl;
    int tid, lane, wave, bid, G;
};

struct CvtRegs { f32x4 v[8]; };
__device__ __forceinline__ void cvt_load(CvtRegs& r, const float* W, int ldw, int n0, int Nvalid, int k0, int lane) {
    const int rs = lane >> 3, c4 = lane & 7; const bool ok = (n0 + 4 * c4) < Nvalid;
#pragma unroll
    for (int i = 0; i < 8; ++i) { const f32x4 t = *(const f32x4*)(W + (size_t)(k0 + 8 * i + rs) * ldw + (ok ? n0 + 4 * c4 : 0)); r.v[i] = ok ? t : (f32x4){0.f, 0.f, 0.f, 0.f}; }
}
__device__ __forceinline__ void cvt_store(const CvtRegs& r, bf16* dst, int ldt, LAS float* scr, int lane) {
    const int rs = lane >> 3, c4 = lane & 7;
#pragma unroll
    for (int i = 0; i < 8; ++i) { LAS float* p = scr + (8 * i + rs) * 33 + 4 * c4; p[0] = r.v[i].x; p[1] = r.v[i].y; p[2] = r.v[i].z; p[3] = r.v[i].w; }
    LDS_WAIT(); asm volatile("" ::: "memory");
    const int c = lane & 7;
#pragma unroll
    for (int j = 0; j < 4; ++j) { const int n = (lane >> 3) + 8 * j; const LAS float* s = scr + (8 * c) * 33 + n;
        u32x4 o; o.x = pk2(s[0 * 33], s[1 * 33]); o.y = pk2(s[2 * 33], s[3 * 33]); o.z = pk2(s[4 * 33], s[5 * 33]); o.w = pk2(s[6 * 33], s[7 * 33]);
        *(u32x4*)(dst + (size_t)n * ldt + 8 * c) = o; }
    LDS_WAIT(); asm volatile("" ::: "memory");
}
struct CvtItem { const float* W; bf16* dst; int ldw, n0, Nvalid, k0, ldt; };
__device__ __forceinline__ CvtItem small_item(unsigned char* ws, ArgsP A, int l, int r) {
    constexpr int I0 = 32 * 224, I1 = 32 * 192, I2 = 8 * 64, I3 = 12 * 64, I4 = 12 * 64;
    CvtItem it;
    if (r < I0) { const int kb = r / 224, nb = r % 224; it = CvtItem{(const float*)A->in[3] + (size_t)l * D * NIN, (bf16*)(ws + WS_W1T) + (size_t)(32 * nb) * D + 64 * kb, NIN, 32 * nb, NIN, 64 * kb, D}; return it; } r -= I0;
    if (r < I1) { const int kb = r / 192, nb = r % 192; it = CvtItem{(const float*)A->in[21] + (size_t)l * D * NGATE, (bf16*)(ws + WS_WGT) + (size_t)(32 * nb) * D + 64 * kb, NGATE, 32 * nb, NGATE, 64 * kb, D}; return it; } r -= I1;
    if (r < I2) { const int kb = r / 64, nb = r % 64; it = CvtItem{(const float*)A->in[18] + (size_t)l * WA * D, (bf16*)(ws + WS_WOUTT) + (size_t)(32 * nb) * D + 0 + 64 * kb, D, 32 * nb, D, 64 * kb, D}; return it; } r -= I2;
    if (r < I3) { const int kb = r / 64, nb = r % 64; it = CvtItem{(const float*)A->in[19] + (size_t)l * WB * D, (bf16*)(ws + WS_WOUTT) + (size_t)(32 * nb) * D + 512 + 64 * kb, D, 32 * nb, D, 64 * kb, D}; return it; } r -= I3;
    if (r < I4) { const int kb = r / 64, nb = r % 64; it = CvtItem{(const float*)A->in[20] + (size_t)l * WC * D, (bf16*)(ws + WS_WOUTT) + (size_t)(32 * nb) * D + 1280 + 64 * kb, D, 32 * nb, D, 64 * kb, D}; return it; } r -= I4;
    { const int kb = r / 64, nb = r % 64; it = CvtItem{(const float*)A->in[23] + (size_t)l * D * D, (bf16*)(ws + WS_WOT) + (size_t)(32 * nb) * D + 64 * kb, D, 32 * nb, D, 64 * kb, D}; return it; }
}
__device__ __forceinline__ void phase_convert(const Frame& F, ArgsP A, int l) {
    LAS float* scr = (LAS float*)(F.lds + F.wave * 8704);
    const int gw = F.bid * 8 + F.wave, NGW = F.G * 8;
    unsigned char* ws = F.ws;
    constexpr int NIT = 32 * 224 + 32 * 192 + 8 * 64 + 12 * 64 + 12 * 64 + 32 * 64;
    CvtRegs cur, nxt; CvtItem ci, ni;
    int it = gw;
    if (it < NIT) { ci = small_item(ws, A, l, it); cvt_load(cur, ci.W, ci.ldw, ci.n0, ci.Nvalid, ci.k0, F.lane); }
    for (; it < NIT; it += NGW) {
        const bool more = it + NGW < NIT;
        if (more) { ni = small_item(ws, A, l, it + NGW); cvt_load(nxt, ni.W, ni.ldw, ni.n0, ni.Nvalid, ni.k0, F.lane); }
        cvt_store(cur, ci.dst, ci.ldt, scr, F.lane);
        if (more) { cur = nxt; ci = ni; }
    }
    const float* w_r = (const float*)A->in[25] + (size_t)l * D * NE;
    float* wrt = (float*)(ws + WS_WRT);
    for (int i = F.bid * 512 + F.tid; i < D * NE; i += F.G * 512) { const int e = i >> 11, k = i & 2047; wrt[i] = w_r[k * NE + e]; }
}
constexpr int N_CVT_UNITS = 768;
__device__ __forceinline__ CvtItem expert_item(unsigned char* ws, ArgsP A, int l, int r) {
    CvtItem it;
    if (r < 32768) { const int up = r >= 16384; if (up) r -= 16384; const int e = r >> 10, kb = (r & 1023) >> 5, nb = r & 31, n0 = 32 * nb;
        const int row = (n0 >> 7) * 256 + (n0 & 127) + up * 128;
        it = CvtItem{(const float*)A->in[up ? 27 : 26] + ((size_t)l * NE + e) * D * FF, (bf16*)(ws + WS_WGU) + ((size_t)e * 2048 + row) * D + 64 * kb, FF, n0, FF, 64 * kb, D};
    } else { r -= 32768; const int e = r >> 10, kb = (r & 1023) >> 6, nb = r & 63;
        it = CvtItem{(const float*)A->in[28] + ((size_t)l * NE + e) * FF * D, (bf16*)(ws + WS_WDN) + ((size_t)e * 2048 + 32 * nb) * FF + 64 * kb, D, 32 * nb, D, 64 * kb, FF}; }
    return it;
}
__device__ __forceinline__ void convert_expert_unit(const Frame& F, ArgsP A, int l, int cu) {
    LAS float* scr = (LAS float*)(F.lds + F.wave * 8704);
    unsigned char* ws = F.ws;
    const int r0 = cu * 64 + F.wave * 8;
    CvtRegs cur, nxt; CvtItem ci = expert_item(ws, A, l, r0), ni;
    cvt_load(cur, ci.W, ci.ldw, ci.n0, ci.Nvalid, ci.k0, F.lane);
#pragma unroll 1
    for (int k = 0; k < 8; ++k) {
        if (k + 1 < 8) { ni = expert_item(ws, A, l, r0 + k + 1); cvt_load(nxt, ni.W, ni.ldw, ni.n0, ni.Nvalid, ni.k0, F.lane); }
        cvt_store(cur, ci.dst, ci.ldt, scr, F.lane);
        if (k + 1 < 8) { cur = nxt; ci = ni; }
    }
}
__device__ __forceinline__ void rms_row_to_bf16(const float* xrow, const float* gain, bf16* orow, int lane) {
    const f32x4* xr = (const f32x4*)xrow + lane; const f32x4* gr = (const f32x4*)gain + lane;
    f32x4 v[8]; float s = 0.f;
#pragma unroll
    for (int j = 0; j < 8; ++j) { v[j] = xr[64 * j]; s += (v[j].x * v[j].x + v[j].y * v[j].y) + (v[j].z * v[j].z + v[j].w * v[j].w); }
    const float rstd = 1.f / sqrtf(wave_sum(s) * (1.f / D) + EPS);
    u32x2* o = (u32x2*)orow + lane;
#pragma unroll
    for (int j = 0; j < 8; ++j) { const f32x4 g = gr[64 * j]; u32x2 w; w.x = pk2(v[j].x * rstd * g.x, v[j].y * rstd * g.y); w.y = pk2(v[j].z * rstd * g.z, v[j].w * rstd * g.w); o[64 * j] = w; }
}
__device__ __forceinline__ void phase_rms_x(const Frame& F, const float* x, const float* gain) {
    const int gw = F.bid * 8 + F.wave, NGW = F.G * 8;
    for (int m = gw; m < M; m += NGW) rms_row_to_bf16(x + (size_t)m * D, gain, (bf16*)(F.ws + WS_XN) + (size_t)m * D, F.lane);
}

__device__ __forceinline__ int krow(int s, int h, int j) { return 16 * s + 8 * (j >> 2) + 4 * h + (j & 3); }
__device__ __forceinline__ int crow(int reg, int h) { return (reg & 3) + 8 * (reg >> 2) + 4 * h; }
__device__ __forceinline__ float softplusf_(float x) { return x > 20.f ? x : log1pf(expf(x)); }

#define MFMA32(a, b, c) __builtin_amdgcn_mfma_f32_32x32x16_bf16((a), (b), (c), 0, 0, 0)
__device__ __forceinline__ bf16x8 pack8(const f32x16& x, int s) {
    u32x4 p; p.x = pk2(x[8 * s + 0], x[8 * s + 1]); p.y = pk2(x[8 * s + 2], x[8 * s + 3]); p.z = pk2(x[8 * s + 4], x[8 * s + 5]); p.w = pk2(x[8 * s + 6], x[8 * s + 7]);
    return __builtin_bit_cast(bf16x8, p);
}
typedef short v4i16_t __attribute__((ext_vector_type(4)));
constexpr int NP_K = 0, NP_Q = 16384, NP_V = 32768, NP_L = 49152, NP_T = 83968, NP_TAB = 139264, NP_CS = 141824, NP_END = 145920;
constexpr int LP = 68;
constexpr int TP = 144;
static_assert(NP_END <= MISC_OFF, "prep lds");
__device__ __forceinline__ int swzf(int row) { return ((row & 3) << 2) | ((row >> 2) & 3); }
__device__ __forceinline__ bf16x8 img_frag(const LAS unsigned char* img, int row, int s, int hh) {
    return *(const LAS bf16x8*)(img + row * 256 + (((2 * s + hh) ^ swzf(row)) << 4)); }
__device__ __forceinline__ s16x4 tr_read4(const LAS unsigned char* p) { return __builtin_bit_cast(s16x4, __builtin_amdgcn_ds_read_tr16_b64_v4i16((LAS v4i16_t*)p)); }
__device__ __forceinline__ bf16x8 img_frag_tr(const LAS unsigned char* img, int s, int cb, int lane, int flip) {
    const int hh = lane >> 5, i16 = lane & 15, q_ = i16 >> 2, p = i16 & 3, blk = (lane >> 4) & 1;
    const int c0 = 16 * s + 4 * hh + q_, r0 = flip ? 63 - c0 : c0, r1 = flip ? 55 - c0 : c0 + 8;
    const int chunk = 4 * cb + 2 * blk + (p >> 1), within = 8 * (p & 1);
    const s16x4 lo = tr_read4(img + r0 * 256 + ((chunk ^ swzf(r0)) << 4) + within), hi = tr_read4(img + r1 * 256 + ((chunk ^ swzf(r1)) << 4) + within);
    return (bf16x8){lo[0], lo[1], lo[2], lo[3], hi[0], hi[1], hi[2], hi[3]};
}

__device__ __forceinline__ void phase_prep(Frame& F, ArgsP A, int l) {
    int& tid = F.tid; int lane = F.lane, wave = F.wave;
    unsigned char* ws = F.ws;
    const bf16* PROJ = (const bf16*)(ws + WS_PROJ);
    bf16* MMIX = (bf16*)(ws + WS_MMIX);
    bf16* QKB = (bf16*)(ws + WS_QKB);
#define RELAUNDER() do { asm volatile("" : "+v"(tid)); lane = tid & 63; wave = __builtin_amdgcn_readfirstlane(tid >> 6); } while (0)
    const float* SCAL = (const float*)(ws + WS_SCAL);
    const float* conv_c = (const float*)A->in[12] + (size_t)l * 3 * 2304;
    LAS float* cs = (LAS float*)(F.lds + NP_CS);

    for (int unit = F.bid; unit < BATCH * NCHUNK; unit += F.G) {
        const int b = unit >> 6, chunk = unit & 63, t0 = chunk * 64, m0 = b * SEQ + t0;
        const bf16* P0 = PROJ + (size_t)m0 * NPROJ;
        RELAUNDER();
#ifndef NO_PREP_AB
#pragma unroll 1
        for (int rab_ = 0; rab_ < (DBLP == 1 ? 2 : 1); ++rab_) {
        {
            const float* conv_a = (const float*)A->in[4] + (size_t)l * 3 * WA;
#pragma unroll 1
            for (int k = 0; k < 4; ++k) {
                const int it = tid + 512 * k, rg = it >> 8, cp = it & 255, r0 = 8 * rg;
                const f32x2 w0 = *(const f32x2*)(conv_a + 0 * WA + 2 * cp), w1 = *(const f32x2*)(conv_a + 1 * WA + 2 * cp), w2 = *(const f32x2*)(conv_a + 2 * WA + 2 * cp);
                unsigned cr[10], vr[10], br[8];
#pragma unroll
                for (int i = 0; i < 10; ++i) { const int r = r0 - 1 + i, t = t0 + r; const bool ok = (t >= 0 && t < SEQ); const bf16* row = P0 + (ptrdiff_t)(ok ? r : r0) * NPROJ;
                    const unsigned c = *(const unsigned*)(row + PC_CA + 2 * cp), v = *(const unsigned*)(row + PC_VA + 2 * cp); cr[i] = ok ? c : 0u; vr[i] = ok ? v : 0u; }
#pragma unroll
                for (int i = 0; i < 8; ++i) br[i] = *(const unsigned*)(P0 + (size_t)(r0 + i) * NPROJ + PC_BA + 2 * cp);
                f32x2 cv[10];
#pragma unroll
                for (int i = 0; i < 10; ++i) cv[i] = (f32x2){bflo(cr[i]) * bflo(vr[i]), bfhi(cr[i]) * bfhi(vr[i])};
#pragma unroll
                for (int i = 0; i < 8; ++i) { const f32x2 y = w0 * cv[i] + w1 * cv[i + 1] + w2 * cv[i + 2];
                    *(unsigned*)(MMIX + (size_t)(m0 + r0 + i) * D + 2 * cp) = pk2(bflo(br[i]) * y.x, bfhi(br[i]) * y.y); }
            }
        }
        RELAUNDER();
        {
            const float* q_norm = (const float*)A->in[5] + l * 64; const float* k_norm = (const float*)A->in[6] + l * 64;
            { const int row = tid >> 3, j = tid & 7; const int pos = ((const int*)A->in[1])[m0 + row];
              const float inv = powf(500000.f, -(float)(2 * j) / 16.f); const float ang = (float)pos * inv;
              cs[row * 16 + j] = cosf(ang); cs[row * 16 + 8 + j] = sinf(ang); }
            __syncthreads();
            const int e8 = lane & 7;
#pragma unroll 1
            for (int it0 = 0; it0 < 24; it0 += 4) {
                u32x4 raws[4];
#pragma unroll
                for (int j = 0; j < 4; ++j) { const int v = (it0 + j) * 64 + wave * 8 + (lane >> 3); const int row = v / 24, vv = v % 24; const int isk = vv >= 12, hc = vv % 12;
                    raws[j] = *(const u32x4*)(P0 + (size_t)row * NPROJ + (isk ? PC_KB : PC_QB) + hc * 64 + 8 * e8); }
#pragma unroll
                for (int j = 0; j < 4; ++j) {
                const int v = (it0 + j) * 64 + wave * 8 + (lane >> 3); const int row = v / 24, vv = v % 24; const int isk = vv >= 12, hc = vv % 12;
                const u32x4 raw = raws[j];
                float x[8]; x[0] = bflo(raw.x); x[1] = bfhi(raw.x); x[2] = bflo(raw.y); x[3] = bfhi(raw.y); x[4] = bflo(raw.z); x[5] = bfhi(raw.z); x[6] = bflo(raw.w); x[7] = bfhi(raw.w);
                float ss = 0.f;
#pragma unroll
                for (int i = 0; i < 8; ++i) ss += x[i] * x[i];
                ss += shx<1>(ss); ss += shx<2>(ss); ss += shx<4>(ss);
                const float rstd = 1.f / sqrtf(ss * (1.f / 64.f) + EPS);
                const float* gn = (isk ? k_norm : q_norm) + 8 * e8;
                float y[8], oth[8];
#pragma unroll
                for (int i = 0; i < 8; ++i) y[i] = x[i] * rstd * gn[i];
#pragma unroll
                for (int i = 0; i < 8; ++i) oth[i] = shx<1>(y[i]);
                if (e8 < 2) {
#pragma unroll
                    for (int i = 0; i < 8; ++i) { const float c = cs[row * 16 + i], s = cs[row * 16 + 8 + i];
                        y[i] = (e8 == 0) ? (y[i] * c - oth[i] * s) : (y[i] * c + oth[i] * s); }
                }
                const float sc = isk ? 1.f : 0.125f * 1.4426950408889634f;
                u32x4 o; o.x = pk2(y[0] * sc, y[1] * sc); o.y = pk2(y[2] * sc, y[3] * sc); o.z = pk2(y[4] * sc, y[5] * sc); o.w = pk2(y[6] * sc, y[7] * sc);
                *(u32x4*)(QKB + (size_t)(m0 + row) * 1536 + (isk ? 768 : 0) + hc * 64 + 8 * e8) = o;
                }
            }
        }
        __syncthreads(); }
#endif
#ifndef NO_PREP_C
        unsigned raw[3][10];
        auto fetch_raw = [&](int hh_) {
#pragma unroll
            for (int mat = 0; mat < 3; ++mat) { const int col = (mat == 0 ? PC_QC : (mat == 1 ? PC_KC : PC_VC)) + hh_ * 128 + 2 * lane;
#pragma unroll
                for (int i = 0; i < 10; ++i) { const int r = 8 * wave - 1 + i, t = t0 + r; const bool ok = (t >= 0 && t < SEQ);
                    const unsigned w = *(const unsigned*)(P0 + (ptrdiff_t)(ok ? r : 8 * wave) * NPROJ + col); raw[mat][i] = ok ? w : 0u; } } };
        fetch_raw(0);
#pragma unroll 1
        for (int hx = 0; hx < (DBLP == 2 ? 2 * HC : HC); ++hx) { const int h = hx % HC;
            LBAR();
            RELAUNDER();
            LAS unsigned char* kimg = F.lds + NP_K; LAS unsigned char* qimg = F.lds + NP_Q; LAS unsigned char* vimg = F.lds + NP_V;
            {
#pragma unroll
                for (int mat = 0; mat < 3; ++mat) {
                    const int wch = mat * 768 + h * 128 + 2 * lane;
                    const f32x2 cw0 = *(const f32x2*)(conv_c + 0 * 2304 + wch), cw1 = *(const f32x2*)(conv_c + 1 * 2304 + wch), cw2 = *(const f32x2*)(conv_c + 2 * 2304 + wch);
                    LAS unsigned char* img = F.lds + (mat == 0 ? NP_Q : (mat == 1 ? NP_K : NP_V));
                    f32x2 xr[10];
#pragma unroll
                    for (int i = 0; i < 10; ++i) xr[i] = (f32x2){bflo(raw[mat][i]), bfhi(raw[mat][i])};
#pragma unroll
                    for (int i = 0; i < 8; ++i) { const int row = 8 * wave + i;
                        f32x2 a = cw0 * xr[i] + cw1 * xr[i + 1] + cw2 * xr[i + 2]; a.x = siluf_(a.x); a.y = siluf_(a.y);
                        if (mat < 2) { const float ss = wave_sum(a.x * a.x + a.y * a.y); const float sc = (1.f / sqrtf(ss + EPS)) * (mat == 0 ? 0.08838834764831845f : 1.f); a.x *= sc; a.y *= sc; }
                        *(LAS unsigned*)(img + row * 256 + (((lane >> 2) ^ swzf(row)) << 4) + (lane & 3) * 4) = pk2(a.x, a.y); }
                }
            }
            if (hx + 1 < (DBLP == 2 ? 2 * HC : HC)) fetch_raw((hx + 1) % HC);
            if (wave < 2) {
                const int d = wave, i = lane, row = d ? 63 - i : i; const float* sc = SCAL + (size_t)(m0 + row) * 32;
                const float beta = sigmoidf_(sc[d * 6 + h]);
                const float a = sc[12 + d * 6 + h];
                const float al = ((const float*)A->in[d ? 14 : 13])[l * 6 + h], db = ((const float*)A->in[d ? 16 : 15])[l * 6 + h];
                float g = -expf(al) * softplusf_(a + db) * 1.4426950408889634f;
#pragma unroll
                for (int o = 1; o < 64; o <<= 1) { const float t = shfl_up_f(g, o, lane); if (lane >= o) g += t; }
                const float glast = __builtin_bit_cast(float, __builtin_amdgcn_readlane(__builtin_bit_cast(int, g), 63));
                LAS float* tab = (LAS float*)(F.lds + NP_TAB) + d * 320;
                const float e2 = __builtin_amdgcn_exp2f(g);
                tab[i] = beta; tab[64 + i] = g; tab[128 + i] = e2; tab[192 + i] = beta * e2; tab[256 + i] = __builtin_amdgcn_exp2f(glast - g);
            }
            LBAR();
            RELAUNDER();
            const int d = wave >> 2, wj = wave & 3, r32 = lane & 31, hh = lane >> 5;
            const LAS float* tab = (const LAS float*)(F.lds + NP_TAB) + d * 320;
            LAS float* Ld = (LAS float*)(F.lds + NP_L) + d * (64 * LP);
            LAS unsigned char* Tp = F.lds + NP_T + d * 27648; LAS unsigned char* Tb = Tp + 9216; LAS unsigned char* Tbg = Tp + 18432;
            const int chain = (b * HC + h) * 2 + d, step = d ? 63 - chunk : chunk;
            const size_t inst = (size_t)chain * 64 + step;
            unsigned char* op = ws + WS_SCANOP + inst * SCANOP_BYTES;
#define FR(i) (d ? 63 - (i) : (i))
            {
                const int kk_mb = (wj == 0) ? 0 : 1, kk_nb = (wj == 1) ? 1 : 0, x_jb = (wj == 1) ? 1 : 0, x_ib = (wj == 0) ? 0 : 1;
                if (wj != 3) {
                    f32x16 acc;
#pragma unroll
                    for (int r = 0; r < 16; ++r) acc[r] = 0.f;
#pragma unroll
                    for (int s = 0; s < 8; ++s) acc = MFMA32(img_frag(kimg, FR(32 * kk_mb + r32), s, hh), img_frag(kimg, FR(32 * kk_nb + r32), s, hh), acc);
                    const int jc = 32 * kk_nb + r32; const float gj = tab[64 + jc];
#pragma unroll
                    for (int r = 0; r < 16; ++r) { const int i = 32 * kk_mb + crow(r, hh);
                        Ld[i * LP + jc] = (jc < i) ? acc[r] * tab[i] * __builtin_amdgcn_exp2f(tab[64 + i] - gj) : 0.f; }
                }
                if (wj != 2) {
                    f32x16 acc;
#pragma unroll
                    for (int r = 0; r < 16; ++r) acc[r] = 0.f;
#pragma unroll
                    for (int s = 0; s < 8; ++s) acc = MFMA32(img_frag(kimg, FR(32 * x_jb + r32), s, hh), img_frag(qimg, FR(32 * x_ib + r32), s, hh), acc);
                    const int i = 32 * x_ib + r32; const float gi = tab[64 + i];
#pragma unroll
                    for (int r = 0; r < 16; ++r) { const int jj = 32 * x_jb + crow(r, hh); acc[r] = (jj <= i) ? acc[r] * __builtin_amdgcn_exp2f(gi - tab[64 + jj]) : 0.f; }
#pragma unroll
                    for (int hf = 0; hf < 2; ++hf) *(bf16x8*)(op + SO_A + ((x_ib * 4 + 2 * x_jb + hf) * 64 + lane) * 16) = pack8(acc, hf);
                }
            }
            LBAR();
            RELAUNDER();
            if (wj == 0) {
                const int i0 = 32 * hh, c = r32; float sol[32];
                f32x4 cur[8], nxt[8];
#pragma unroll
                for (int j4 = 0; j4 < 8; ++j4) { cur[j4] = (f32x4){0.f, 0.f, 0.f, 0.f}; nxt[j4] = cur[j4]; }
                sol[0] = (c == 0) ? 1.f : 0.f;
                cur[0] = *(const LAS f32x4*)(Ld + (i0 + 1) * LP + i0);
#pragma unroll
                for (int i = 1; i < 32; ++i) {
                    if (i + 1 < 32) {
#pragma unroll
                        for (int j4 = 0; j4 < (i + 4) / 4; ++j4) nxt[j4] = *(const LAS f32x4*)(Ld + (i0 + i + 1) * LP + i0 + 4 * j4);
                    }
                    float a0 = (i == c) ? 1.f : 0.f, a1 = 0.f, a2 = 0.f, a3 = 0.f;
#pragma unroll
                    for (int j4 = 0; j4 < (i + 3) / 4; ++j4) { const f32x4 lv = cur[j4];
                        if (4 * j4 + 0 < i) a0 -= lv.x * sol[4 * j4 + 0]; if (4 * j4 + 1 < i) a1 -= lv.y * sol[4 * j4 + 1];
                        if (4 * j4 + 2 < i) a2 -= lv.z * sol[4 * j4 + 2]; if (4 * j4 + 3 < i) a3 -= lv.w * sol[4 * j4 + 3]; }
                    float a = (a0 + a1) + (a2 + a3);
                    asm volatile("" : "+v"(a) :: "memory"); sol[i] = a;
#pragma unroll
                    for (int j4 = 0; j4 < 8; ++j4) cur[j4] = nxt[j4];
                }
                const float bc = tab[i0 + c], bgc = tab[192 + i0 + c];
#pragma unroll
                for (int i = 0; i < 32; ++i) { const int off = (i0 + i) * TP + (i0 + c) * 2;
                    *(LAS bf16*)(Tp + off) = (bf16)f2bf(sol[i]); *(LAS bf16*)(Tb + off) = (bf16)f2bf(sol[i] * bc); *(LAS bf16*)(Tbg + off) = (bf16)f2bf(sol[i] * bgc);
                    if (hh == 1) { const int zo = i * TP + (32 + c) * 2; *(LAS bf16*)(Tb + zo) = 0; *(LAS bf16*)(Tbg + zo) = 0; } }
            } else {
#pragma unroll 1
                for (int f = wj - 1; f < 32; f += 3) {
                    if (f < 16) {
                        const int mb = f >> 3, s = f & 7, i = 32 * mb + r32, row = FR(i); const float eg = tab[128 + i];
                        const LAS unsigned char* rp = qimg + row * 256 + 8 * hh;
                        const u32x2 lo = *(const LAS u32x2*)(rp + (((2 * s) ^ swzf(row)) << 4)), hi = *(const LAS u32x2*)(rp + (((2 * s + 1) ^ swzf(row)) << 4));
                        u32x4 o; o.x = pk2(bflo(lo.x) * eg, bfhi(lo.x) * eg); o.y = pk2(bflo(lo.y) * eg, bfhi(lo.y) * eg); o.z = pk2(bflo(hi.x) * eg, bfhi(hi.x) * eg); o.w = pk2(bflo(hi.y) * eg, bfhi(hi.y) * eg);
                        *(u32x4*)(op + SO_Q + (f * 64 + lane) * 16) = o;
                    } else {
                        const int g = f - 16, a = g >> 2, s = g & 3;
                        const bf16x8 kf = img_frag_tr(kimg, s, a, lane, d);
                        const f32x4 d0 = *(const LAS f32x4*)(tab + 256 + 16 * s + 4 * hh), d1 = *(const LAS f32x4*)(tab + 256 + 16 * s + 8 + 4 * hh);
                        u32x4 o; o.x = pk2(bf2f((bf16)kf[0]) * d0.x, bf2f((bf16)kf[1]) * d0.y); o.y = pk2(bf2f((bf16)kf[2]) * d0.z, bf2f((bf16)kf[3]) * d0.w);
                        o.z = pk2(bf2f((bf16)kf[4]) * d1.x, bf2f((bf16)kf[5]) * d1.y); o.w = pk2(bf2f((bf16)kf[6]) * d1.z, bf2f((bf16)kf[7]) * d1.w);
                        *(u32x4*)(op + SO_K + (g * 64 + lane) * 16) = o;
                    }
                }
                if (wj == 1 && lane == 0) ((float*)(ws + WS_EW + 256 * 1024))[inst] = tab[128 + 63];
            }
            LBAR();
            RELAUNDER();
            if (wj == 0) {
                f32x16 P;
#pragma unroll
                for (int r = 0; r < 16; ++r) P[r] = 0.f;
#pragma unroll
                for (int s = 0; s < 2; ++s) {
                    const LAS float* lp = Ld + (32 + r32) * LP + 16 * s + 4 * hh; const f32x4 l0 = *(const LAS f32x4*)lp, l1 = *(const LAS f32x4*)(lp + 8);
                    u32x4 aw; aw.x = pk2(l0.x, l0.y); aw.y = pk2(l0.z, l0.w); aw.z = pk2(l1.x, l1.y); aw.w = pk2(l1.z, l1.w);
                    const int i16 = lane & 15, q_ = i16 >> 2, p = i16 & 3, blk = (lane >> 4) & 1;
                    const LAS unsigned char* tp = Tp + (16 * s + 4 * hh + q_) * TP + blk * 32 + p * 8;
                    const s16x4 lo = tr_read4(tp), hi = tr_read4(tp + 8 * TP);
                    P = MFMA32(__builtin_bit_cast(bf16x8, aw), ((bf16x8){lo[0], lo[1], lo[2], lo[3], hi[0], hi[1], hi[2], hi[3]}), P);
                }
                f32x16 T21;
#pragma unroll
                for (int r = 0; r < 16; ++r) T21[r] = 0.f;
#pragma unroll
                for (int s = 0; s < 2; ++s) {
                    const LAS unsigned char* tp = Tp + (32 + r32) * TP + (32 + 16 * s + 4 * hh) * 2;
                    const u32x2 lo = *(const LAS u32x2*)tp, hi = *(const LAS u32x2*)(tp + 16);
                    u32x4 aw; aw.x = lo.x; aw.y = lo.y; aw.z = hi.x; aw.w = hi.y;
                    T21 = MFMA32(__builtin_bit_cast(bf16x8, aw), pack8(P, s), T21);
                }
                const float bc = tab[r32], bgc = tab[192 + r32];
#pragma unroll
                for (int r = 0; r < 16; ++r) { const int off = (32 + crow(r, hh)) * TP + r32 * 2; const float v = -T21[r];
                    *(LAS bf16*)(Tb + off) = (bf16)f2bf(v * bc); *(LAS bf16*)(Tbg + off) = (bf16)f2bf(v * bgc); }
            }
            LBAR();
            RELAUNDER();
            {
                f32x16 au[2], aw[2];
#pragma unroll
                for (int mb = 0; mb < 2; ++mb)
#pragma unroll
                    for (int r = 0; r < 16; ++r) { au[mb][r] = 0.f; aw[mb][r] = 0.f; }
#pragma unroll
                for (int s = 0; s < 4; ++s) {
                    const bf16x8 vf = img_frag_tr(vimg, s, wj, lane, d), kf = img_frag_tr(kimg, s, wj, lane, d);
#pragma unroll
                    for (int mb = 0; mb < 2; ++mb) {
                        if (mb == 0 && s >= 2) continue;
                        const int to = (32 * mb + r32) * TP + (16 * s + 4 * hh) * 2;
                        const u32x2 b0 = *(const LAS u32x2*)(Tb + to), b1 = *(const LAS u32x2*)(Tb + to + 16), g0 = *(const LAS u32x2*)(Tbg + to), g1 = *(const LAS u32x2*)(Tbg + to + 16);
                        u32x4 tbw, tgw; tbw.x = b0.x; tbw.y = b0.y; tbw.z = b1.x; tbw.w = b1.y; tgw.x = g0.x; tgw.y = g0.y; tgw.z = g1.x; tgw.w = g1.y;
                        au[mb] = MFMA32(__builtin_bit_cast(bf16x8, tbw), vf, au[mb]);
                        aw[mb] = MFMA32(kf, __builtin_bit_cast(bf16x8, tgw), aw[mb]);
                    }
                }
#pragma unroll
                for (int mb = 0; mb < 2; ++mb) {
                    u32x4 o0, o1; o0.x = pk2(au[mb][0], au[mb][1]); o0.y = pk2(au[mb][2], au[mb][3]); o0.z = pk2(au[mb][4], au[mb][5]); o0.w = pk2(au[mb][6], au[mb][7]);
                    o1.x = pk2(au[mb][8], au[mb][9]); o1.y = pk2(au[mb][10], au[mb][11]); o1.z = pk2(au[mb][12], au[mb][13]); o1.w = pk2(au[mb][14], au[mb][15]);
                    u32x4* up = (u32x4*)(op + SO_U + ((wj * 2 + mb) * 64 + lane) * 32); up[0] = o0; up[1] = o1;
#pragma unroll
                    for (int r = 0; r < 16; ++r) aw[mb][r] = -aw[mb][r];
#pragma unroll
                    for (int hf = 0; hf < 2; ++hf) *(bf16x8*)(op + SO_W + ((mb * 8 + 2 * wj + hf) * 64 + lane) * 16) = pack8(aw[mb], hf);
                }
            }
#undef FR
        }
#endif
        __syncthreads();
    }
#undef RELAUNDER
}

constexpr int SC_GE = 2 * SCANOP_BYTES;
static_assert(SC_GE + 64 <= MISC_OFF, "scan lds");
__device__ __forceinline__ void scan_chain_wg(const Frame& F, int chain) {
    unsigned char* ws = F.ws; const int lane = F.lane, wave = F.wave;
    const int b = chain / 12, h = (chain >> 1) % 6, d = chain & 1;
    const unsigned char* op0 = ws + WS_SCANOP + (size_t)chain * 64 * SCANOP_BYTES;
    const float* GE = (const float*)(ws + WS_EW + 256 * 1024) + chain * 64;
    float* O = (float*)(ws + (d ? WS_OB : WS_OF));
    const int r32 = lane & 31, hh = lane >> 5;
    LAS unsigned char* lds = F.lds;
    const bool loader = wave >= 4;
    auto fill = [&](int step, int buf) {
        const unsigned char* src = op0 + (size_t)step * SCANOP_BYTES + (wave - 4) * 1024 + lane * 16;
        asm volatile("" : "+v"(src));
#pragma unroll
        for (int k = 0; k < 18; ++k) { const int pi = (wave - 4) + 4 * k;
            __builtin_amdgcn_global_load_lds((const unsigned*)(src + k * 4096), (LAS unsigned*)(lds + buf * SCANOP_BYTES + pi * 1024), 16, 0, 0); }
        if (wave == 4 && lane == 0) *(LAS float*)(lds + SC_GE + 4 * buf) = GE[step];
    };
    f32x16 S[4];
#pragma unroll
    for (int a = 0; a < 4; ++a)
#pragma unroll
        for (int r = 0; r < 16; ++r) S[a][r] = 0.f;
    if (loader) fill(0, 0);
    asm volatile("s_waitcnt vmcnt(0) lgkmcnt(0)" ::: "memory"); __builtin_amdgcn_s_barrier(); asm volatile("" ::: "memory");
    for (int step = 0; step < 64; ++step) {
        const int buf = step & 1;
        if (loader) {
            if (step + 1 < 64) fill(step + 1, buf ^ 1);
            asm volatile("s_waitcnt vmcnt(0) lgkmcnt(0)" ::: "memory");
        } else {
            const int slice = wave;
            const int chunk = d ? 63 - step : step;
            const LAS unsigned char* op = lds + buf * SCANOP_BYTES + lane * 16;
            const float ge = *(const LAS float*)(lds + SC_GE + 4 * buf);
            bf16x8 Sb[8];
#pragma unroll
            for (int a = 0; a < 4; ++a) { Sb[2 * a] = pack8(S[a], 0); Sb[2 * a + 1] = pack8(S[a], 1); }
            f32x16 vn[2];
#pragma unroll
            for (int mb = 0; mb < 2; ++mb) {
                const LAS u32x4* up = (const LAS u32x4*)(lds + buf * SCANOP_BYTES + SO_U + ((slice * 2 + mb) * 64 + lane) * 32);
                const u32x4 u0 = up[0], u1 = up[1];
                vn[mb][0] = bflo(u0.x); vn[mb][1] = bfhi(u0.x); vn[mb][2] = bflo(u0.y); vn[mb][3] = bfhi(u0.y); vn[mb][4] = bflo(u0.z); vn[mb][5] = bfhi(u0.z); vn[mb][6] = bflo(u0.w); vn[mb][7] = bfhi(u0.w);
                vn[mb][8] = bflo(u1.x); vn[mb][9] = bfhi(u1.x); vn[mb][10] = bflo(u1.y); vn[mb][11] = bfhi(u1.y); vn[mb][12] = bflo(u1.z); vn[mb][13] = bfhi(u1.z); vn[mb][14] = bflo(u1.w); vn[mb][15] = bfhi(u1.w);
            }
#pragma unroll
            for (int s = 0; s < 8; ++s)
#pragma unroll
                for (int mb = 0; mb < 2; ++mb) vn[mb] = MFMA32(*(const LAS bf16x8*)(op + SO_W + (mb * 8 + s) * 1024), Sb[s], vn[mb]);
            asm volatile("" ::: "memory"); __builtin_amdgcn_sched_barrier(0);
            bf16x8 Vb[4];
#pragma unroll
            for (int mb = 0; mb < 2; ++mb) { Vb[2 * mb] = pack8(vn[mb], 0); Vb[2 * mb + 1] = pack8(vn[mb], 1); }
#pragma unroll
            for (int a = 0; a < 4; ++a) {
#pragma unroll
                for (int r = 0; r < 16; ++r) S[a][r] *= ge;
            }
#pragma unroll
            for (int s = 0; s < 4; ++s)
#pragma unroll
                for (int a = 0; a < 4; ++a) S[a] = MFMA32(*(const LAS bf16x8*)(op + SO_K + (a * 4 + s) * 1024), Vb[s], S[a]);
            asm volatile("" ::: "memory"); __builtin_amdgcn_sched_barrier(0);
            f32x16 o[2];
#pragma unroll
            for (int mb = 0; mb < 2; ++mb)
#pragma unroll
                for (int r = 0; r < 16; ++r) o[mb][r] = 0.f;
#pragma unroll
            for (int s = 0; s < 8; ++s)
#pragma unroll
                for (int mb = 0; mb < 2; ++mb) o[mb] = MFMA32(*(const LAS bf16x8*)(op + SO_Q + (mb * 8 + s) * 1024), Sb[s], o[mb]);
            asm volatile("" ::: "memory"); __builtin_amdgcn_sched_barrier(0);
#pragma unroll
            for (int mb = 0; mb < 2; ++mb)
#pragma unroll
                for (int s = 0; s < 2 * (mb + 1); ++s) o[mb] = MFMA32(*(const LAS bf16x8*)(op + SO_A + (mb * 4 + s) * 1024), Vb[s], o[mb]);
            float* Ou = O + (size_t)(b * SEQ + chunk * 64) * WC + h * 128 + 32 * slice;
            const int voff = (d ? 4 - 4 * hh : 4 * hh) * WC + r32;
#pragma unroll
            for (int mb = 0; mb < 2; ++mb)
#pragma unroll
                for (int r = 0; r < 16; ++r) { const int ri = 32 * mb + (r & 3) + 8 * (r >> 2); float* rowp = Ou + (d ? 59 - ri : ri) * WC; rowp[voff] = o[mb][r]; }
            asm volatile("s_waitcnt lgkmcnt(0)" ::: "memory");
        }
        asm volatile("" ::: "memory"); __builtin_amdgcn_s_barrier(); asm volatile("" ::: "memory");
    }
}

__device__ __forceinline__ void glds16(const void* gsrc, unsigned lds_dst) { unsigned keep;
    asm volatile("s_mov_b32 %0, m0\n\ts_mov_b32 m0, %2\n\ts_nop 0\n\tglobal_load_lds_dwordx4 %1, off\n\ts_mov_b32 m0, %0" : "=&s"(keep) : "v"(gsrc), "s"(lds_dst) : "memory"); }
constexpr int AL_K = 0, AL_V = 18432, AL_BUF = 34816, AL_OST = 0, AL_LST = 65536, AL_LTAB = 66048;
static_assert(3 * AL_BUF <= MISC_OFF && AL_LTAB + 512 <= 3 * AL_BUF, "attn lds");
__device__ __forceinline__ void attn_unit(const Frame& F, int b, int h, int qb, float lam, float negM2, const float* subln, float out_scale) {
    const int lane = F.lane, wave = F.wave, qg = wave & 3, c = wave >> 2, r32 = lane & 31, hh = lane >> 5;
    unsigned char* ws = F.ws;
    const bf16* QKB = (const bf16*)(ws + WS_QKB);
    const bf16* PROJ = (const bf16*)(ws + WS_PROJ);
    bf16* MMIX = (bf16*)(ws + WS_MMIX);
    const size_t rowb = (size_t)b * SEQ;
    bf16x8 qf[4];
    { const bf16* Qrow = QKB + (rowb + qb * 128 + qg * 32 + r32) * 1536 + h * 128 + c * 64;
#pragma unroll
      for (int s = 0; s < 4; ++s) qf[s] = *(const bf16x8*)(Qrow + 16 * s + 8 * hh);
      asm volatile("" :: "v"(qf[0]), "v"(qf[1]), "v"(qf[2]), "v"(qf[3])); }
    f32x16 O[4];
#pragma unroll
    for (int db = 0; db < 4; ++db)
#pragma unroll
        for (int r = 0; r < 16; ++r) O[db][r] = 0.f;
    float lsum = 0.f;
    unsigned doff[5];
#pragma unroll
    for (int k = 0; k < 5; ++k) { int pi = wave + 8 * k; if (pi >= 34) pi -= 8;
        const int p = pi * 64 + lane; unsigned o = 0u;
        if (pi < 18) { const int cc = p / 576, q = p % 576, row = q / 9; int ch = q % 9; ch = ch > 7 ? 7 : ch; o = (unsigned)((row * 1536 + cc * 64 + 8 * ch) * 2); }
        else { const int pp = p - 1152, db = pp >> 8, row = (pp >> 2) & 63, c4 = pp & 3; o = (unsigned)((row * NPROJ + 32 * db + 8 * c4) * 2); }
        doff[k] = o; }
    const char* kbase = (const char*)(QKB + rowb * 1536 + 768 + h * 128);
    const char* vbase = (const char*)(PROJ + rowb * NPROJ + PC_VB + h * 128);
    const unsigned lds0 = (unsigned)(uintptr_t)F.lds;
    auto dma = [&](int T, int buf) {
        const char* kb = kbase + (size_t)T * (64 * 1536 * 2); const char* vb = vbase + (size_t)T * (64 * NPROJ * 2);
#pragma unroll
        for (int k = 0; k < 5; ++k) { int pi = wave + 8 * k; if (pi >= 34) pi -= 8;
            glds16((pi < 18 ? kb : vb) + doff[k], (unsigned)__builtin_amdgcn_readfirstlane((int)(lds0 + buf * AL_BUF + pi * 1024))); } };
    dma(0, 0); dma(1, 1);
    const int vlane = ((lane >> 4) & 1) * 32 + (lane & 3) * 8 + (4 * hh + ((lane & 15) >> 2)) * 64;
    int bcur = 0, bnxt2 = 2;
    for (int T = 0; T < 64; ++T) {
        if (T + 1 < 64) asm volatile("s_waitcnt vmcnt(5)" ::: "memory"); else asm volatile("s_waitcnt vmcnt(0)" ::: "memory");
        asm volatile("s_waitcnt lgkmcnt(0)" ::: "memory"); __builtin_amdgcn_s_barrier(); asm volatile("" ::: "memory");
        if (T + 2 < 64) dma(T + 2, bnxt2);
        const LAS unsigned char* lbuf = F.lds + bcur * AL_BUF;
        bcur = (bcur == 2) ? 0 : bcur + 1; bnxt2 = (bnxt2 == 2) ? 0 : bnxt2 + 1;
        const unsigned ka = (unsigned)(uintptr_t)(lbuf + AL_K + c * 9216) + (unsigned)(r32 * 144 + 16 * hh);
        const unsigned va = (unsigned)(uintptr_t)(lbuf + AL_V) + (unsigned)vlane;
#define KRD(dst, off) asm volatile("ds_read_b128 %0, %1 offset:%c2" : "=&v"(dst) : "v"(ka), "i"(off) : "memory")
#define VRD(dst, off) asm volatile("ds_read_b64_tr_b16 %0, %1 offset:%c2" : "=&v"(dst) : "v"(va), "i"(off) : "memory")
#define VGRP(L, H, db_) do { VRD(L[0], (db_) * 4096); VRD(H[0], (db_) * 4096 + 512); VRD(L[1], (db_) * 4096 + 1024); VRD(H[1], (db_) * 4096 + 1536); \
            VRD(L[2], (db_) * 4096 + 2048); VRD(H[2], (db_) * 4096 + 2560); VRD(L[3], (db_) * 4096 + 3072); VRD(H[3], (db_) * 4096 + 3584); } while (0)
#define VWAIT(N, L, H) asm volatile("s_waitcnt lgkmcnt(" #N ")" : "+v"(L[0]), "+v"(H[0]), "+v"(L[1]), "+v"(H[1]), "+v"(L[2]), "+v"(H[2]), "+v"(L[3]), "+v"(H[3]) :: "memory")
#define VFR(L, H, s_) ((bf16x8){L[s_][0], L[s_][1], L[s_][2], L[s_][3], H[s_][0], H[s_][1], H[s_][2], H[s_][3]})
        bf16x8 kf[8];
        KRD(kf[0], 0); KRD(kf[1], 32); KRD(kf[2], 64); KRD(kf[3], 96); KRD(kf[4], 4608); KRD(kf[5], 4640); KRD(kf[6], 4672); KRD(kf[7], 4704);
        asm volatile("s_waitcnt lgkmcnt(4)" : "+v"(kf[0]), "+v"(kf[1]), "+v"(kf[2]), "+v"(kf[3]) :: "memory");
        f32x16 s0, s1;
#pragma unroll
        for (int r = 0; r < 16; ++r) { s0[r] = negM2; s1[r] = negM2; }
#pragma unroll
        for (int s = 0; s < 4; ++s) s0 = MFMA32(kf[s], qf[s], s0);
        asm volatile("s_waitcnt lgkmcnt(0)" : "+v"(kf[4]), "+v"(kf[5]), "+v"(kf[6]), "+v"(kf[7]) :: "memory");
#pragma unroll
        for (int s = 0; s < 4; ++s) s1 = MFMA32(kf[4 + s], qf[s], s1);
        s16x4 vl0[4], vh0[4], vl1[4], vh1[4];
        VGRP(vl0, vh0, 0);
        bf16x8 pf[4];
        { float ls = 0.f;
#pragma unroll
          for (int r = 0; r < 16; ++r) { s0[r] = __builtin_amdgcn_exp2f(s0[r]); ls += s0[r]; }
          pf[0] = pack8(s0, 0); pf[1] = pack8(s0, 1);
#pragma unroll
          for (int r = 0; r < 16; ++r) { s1[r] = __builtin_amdgcn_exp2f(s1[r]); ls += s1[r]; }
          pf[2] = pack8(s1, 0); pf[3] = pack8(s1, 1);
          lsum += ls; }
        VGRP(vl1, vh1, 1);
        VWAIT(8, vl0, vh0);
#pragma unroll
        for (int s = 0; s < 4; ++s) O[0] = MFMA32(pf[s], VFR(vl0, vh0, s), O[0]);
        s16x4 vl2[4], vh2[4];
        VGRP(vl2, vh2, 2);
        VWAIT(8, vl1, vh1);
#pragma unroll
        for (int s = 0; s < 4; ++s) O[1] = MFMA32(pf[s], VFR(vl1, vh1, s), O[1]);
        s16x4 vl3[4], vh3[4];
        VGRP(vl3, vh3, 3);
        VWAIT(8, vl2, vh2);
#pragma unroll
        for (int s = 0; s < 4; ++s) O[2] = MFMA32(pf[s], VFR(vl2, vh2, s), O[2]);
        VWAIT(0, vl3, vh3);
#pragma unroll
        for (int s = 0; s < 4; ++s) O[3] = MFMA32(pf[s], VFR(vl3, vh3, s), O[3]);
#undef KRD
#undef VRD
#undef VGRP
#undef VWAIT
#undef VFR
    }
    lsum += shx<32>(lsum);
    LAS float* Ost = (LAS float*)(F.lds + AL_OST); LAS float* Lst = (LAS float*)(F.lds + AL_LST); LAS float* Ltab = (LAS float*)(F.lds + AL_LTAB);
    __syncthreads();
    if (c == 1) {
        if (hh == 0) Lst[qg * 32 + r32] = lsum;
#pragma unroll
        for (int db = 0; db < 4; ++db)
#pragma unroll
            for (int r = 0; r < 16; ++r) Ost[((qg * 4 + db) * 16 + r) * 64 + lane] = O[db][r];
    } else if (hh == 0) Ltab[qg * 32 + r32] = lsum;
    __syncthreads();
    if (c == 0) {
#pragma unroll
        for (int r = 0; r < 16; ++r) {
            const int q = crow(r, hh);
            const float i0 = 1.f / Ltab[qg * 32 + q], i1 = lam / Lst[qg * 32 + q];
            float ss = 0.f;
#pragma unroll
            for (int db = 0; db < 4; ++db) { const float v = O[db][r] * i0 - Ost[((qg * 4 + db) * 16 + r) * 64 + lane] * i1; O[db][r] = v; ss += v * v; }
            ss += shx<1>(ss); ss += shx<2>(ss); ss += shx<4>(ss); ss += shx<8>(ss); ss += shx<16>(ss);
            const float rstd = out_scale / sqrtf(ss * (1.f / 128.f) + EPS);
            bf16* orow = MMIX + (rowb + qb * 128 + qg * 32 + q) * D + WA + h * 128 + r32;
#pragma unroll
            for (int db = 0; db < 4; ++db) orow[32 * db] = (bf16)f2bf(O[db][r] * rstd * subln[32 * db + r32]);
        }
    }
    __syncthreads();
}

__device__ __forceinline__ void phase_delta_fin(const Frame& F, const float* o_norm) {
    const int gw = F.bid * 8 + F.wave, NGW = F.G * 8, lane = F.lane;
    const float* OF = (const float*)(F.ws + WS_OF); const float* OB = (const float*)(F.ws + WS_OB);
    const bf16* PROJ = (const bf16*)(F.ws + WS_PROJ); bf16* MMIX = (bf16*)(F.ws + WS_MMIX);
    const f32x2 gn = *(const f32x2*)(o_norm + 2 * lane);
    for (int m = 2 * gw; m < M; m += 2 * NGW) {
        f32x2 a[2][HC], c[2][HC]; unsigned g[2][HC];
#pragma unroll
        for (int r = 0; r < 2; ++r)
#pragma unroll
            for (int h = 0; h < HC; ++h) { a[r][h] = *(const f32x2*)(OF + (size_t)(m + r) * WC + h * 128 + 2 * lane); c[r][h] = *(const f32x2*)(OB + (size_t)(m + r) * WC + h * 128 + 2 * lane);
                g[r][h] = *(const unsigned*)(PROJ + (size_t)(m + r) * NPROJ + PC_GC + h * 128 + 2 * lane); }
#pragma unroll
        for (int r = 0; r < 2; ++r)
#pragma unroll
            for (int h = 0; h < HC; ++h) {
                const float o0 = a[r][h].x + c[r][h].x, o1 = a[r][h].y + c[r][h].y;
                const float rstd = 1.f / sqrtf(wave_sum(o0 * o0 + o1 * o1) * (1.f / 128.f) + EPS);
                *(unsigned*)(MMIX + (size_t)(m + r) * D + WA + WB + h * 128 + 2 * lane) = pk2(o0 * rstd * gn.x * siluf_(bflo(g[r][h])), o1 * rstd * gn.y * siluf_(bfhi(g[r][h])));
            }
    }
}

__device__ __forceinline__ void tile_of(int L, int nM, int nN, int& pm, int& pn) {
    const int nwg = nM * nN; int wgid = L; { const int q = nwg / 8, r = nwg % 8, xcd = wgid % 8, off = wgid / 8; wgid = (xcd < r ? xcd * (q + 1) : r * (q + 1) + (xcd - r) * q) + off; }
    const int nig = 8 * nN, gid = wgid / nig, fm = gid * 8, gsz = (nM - fm) < 8 ? (nM - fm) : 8;
    pm = fm + ((wgid % nig) % gsz); pn = (wgid % nig) / gsz;
}
struct SchedPlain {
    const char* A; const char* Bt; int lda, ldb, nM, nN, nt, G, c;
    __device__ __forceinline__ bool next(int i, pg8::Unit& u) const {
        const long L = (long)i * G + c; if (L >= (long)nM * nN) return false;
        int pm, pn; tile_of((int)L, nM, nN, pm, pn);
        u.a = A + (size_t)pm * 256 * lda * 2; u.b = Bt + (size_t)pn * 256 * ldb * 2; u.nt = nt; u.pm = pm; u.pn = pn; u.aux = 0; return true; }
    __device__ __forceinline__ int row_index(const pg8::Unit&, int) const { return 0; }
};
struct SchedOutProj {
    const char* A; const char* Bt; int G, c;
    __device__ __forceinline__ bool next(int i, pg8::Unit& u) const {
        const int ti = i / 3, br = i - 3 * ti; const long L = (long)ti * G + c; if (L >= 512) return false;
        int pm, pn; tile_of((int)L, 64, 8, pm, pn);
        const int koff = br == 0 ? 0 : (br == 1 ? 512 : 1280);
        u.a = A + ((size_t)pm * 256 * D + koff) * 2; u.b = Bt + ((size_t)pn * 256 * D + koff) * 2; u.nt = br == 0 ? 8 : 12; u.pm = pm; u.pn = pn; u.aux = br; return true; }
    __device__ __forceinline__ int row_index(const pg8::Unit&, int) const { return 0; }
};
struct SchedExpert {
    const char* A; const char* Bt; int lda, ldb, nt, G, c;
    __device__ __forceinline__ bool next(int i, pg8::Unit& u) const {
        const long L = (long)i * G + c; if (L >= 1024) return false;
        const int e = (int)L >> 6, rem = (int)L & 63, pm = rem & 7, pn = rem >> 3;
        const int row0 = ((pm >> 1) * 16 + e) * 512 + (pm & 1) * 256;
        u.a = A + (size_t)row0 * lda * 2; u.b = Bt + ((size_t)e * 2048 + pn * 256) * ldb * 2; u.nt = nt; u.pm = row0; u.pn = pn; u.aux = e; return true; }
    __device__ __forceinline__ int row_index(const pg8::Unit&, int) const { return 0; }
};
struct SchedExpertGather {
    const char* A; const char* Bt; const int* idx; int ldb, nt, G, c;
    __device__ __forceinline__ bool next(int i, pg8::Unit& u) const {
        const long L = (long)i * G + c; if (L >= 1024) return false;
        const int e = (int)L >> 6, rem = (int)L & 63, pm = rem & 7, pn = rem >> 3;
        const int row0 = ((pm >> 1) * 16 + e) * 512 + (pm & 1) * 256;
        u.a = A; u.b = Bt + ((size_t)e * 2048 + pn * 256) * ldb * 2; u.nt = nt; u.pm = row0; u.pn = pn; u.aux = e; return true; }
    __device__ __forceinline__ int row_index(const pg8::Unit& u, int r) const { return (u.pm >> 13) * SEQ + idx[u.pm + r]; }
};
typedef f32x4 acc_t[2][2][4][2];
struct EpiProj {
    static constexpr bool PERM = true; static constexpr bool KEEPS = false;
    bf16* proj; float* scal; unsigned char* gates; const float* bias;
    __device__ __forceinline__ void operator()(const acc_t& acc, const pg8::Unit& u, int wr, int wc, int fr, int fq) const {
        const int row0 = u.pm * 256 + wr * 64 + fr;
        if (u.pn < 27) {
            const int col0 = u.pn * 256 + wc * 32 + 8 * fq;
#pragma unroll
            for (int ai = 0; ai < 2; ++ai)
#pragma unroll
                for (int m = 0; m < 4; ++m) { bf16* rowp = proj + (size_t)(row0 + ai * 128 + m * 16) * NPROJ + col0;
#pragma unroll
                    for (int bj = 0; bj < 2; ++bj) { const f32x4 v0 = acc[ai][bj][m][0], v1 = acc[ai][bj][m][1];
                        u32x4 w; w.x = pk2(v0[0], v0[1]); w.y = pk2(v0[2], v0[3]); w.z = pk2(v1[0], v1[1]); w.w = pk2(v1[2], v1[3]);
                        *(u32x4*)(rowp + bj * 128) = w; } }
        } else if (u.pn == 27) {
            if (wc == 0) {
            const int col0 = 8 * fq;
#pragma unroll
            for (int ai = 0; ai < 2; ++ai)
#pragma unroll
                for (int m = 0; m < 4; ++m) { float* rowp = scal + (size_t)(row0 + ai * 128 + m * 16) * 32 + col0;
                    *(f32x4*)rowp = acc[ai][0][m][0]; *(f32x4*)(rowp + 4) = acc[ai][0][m][1]; }
            }
        } else {
            const int col0 = (u.pn - 28) * 256 + wc * 32 + 8 * fq;
            f32x4 bv[2][2];
#pragma unroll
            for (int bj = 0; bj < 2; ++bj)
#pragma unroll
                for (int n = 0; n < 2; ++n) bv[bj][n] = *(const f32x4*)(bias + col0 + bj * 128 + 4 * n);
#pragma unroll
            for (int ai = 0; ai < 2; ++ai)
#pragma unroll
                for (int m = 0; m < 4; ++m) { unsigned char* rowp = gates + (size_t)(row0 + ai * 128 + m * 16) * NGATE + col0;
#pragma unroll
                    for (int bj = 0; bj < 2; ++bj) { const f32x4 v0 = acc[ai][bj][m][0] + bv[bj][0], v1 = acc[ai][bj][m][1] + bv[bj][1];
#define Q8(x) ((unsigned)__builtin_rintf(255.f * sigmoidf_(x)))
                        u32x2 w; w.x = Q8(v0[0]) | (Q8(v0[1]) << 8) | (Q8(v0[2]) << 16) | (Q8(v0[3]) << 24); w.y = Q8(v1[0]) | (Q8(v1[1]) << 8) | (Q8(v1[2]) << 16) | (Q8(v1[3]) << 24);
#undef Q8
                        *(u32x2*)(rowp + bj * 128) = w; } }
        }
    }
};
struct EpiGate {
    static constexpr bool PERM = true; static constexpr bool KEEPS = false;
    bf16* gates; const float* bias;
    __device__ __forceinline__ void operator()(const acc_t& acc, const pg8::Unit& u, int wr, int wc, int fr, int fq) const {
        const int row0 = u.pm * 256 + wr * 64 + fr, col0 = u.pn * 256 + wc * 32 + 8 * fq;
        f32x4 bv[2][2];
#pragma unroll
        for (int bj = 0; bj < 2; ++bj)
#pragma unroll
            for (int n = 0; n < 2; ++n) bv[bj][n] = *(const f32x4*)(bias + col0 + bj * 128 + 4 * n);
#pragma unroll
        for (int ai = 0; ai < 2; ++ai)
#pragma unroll
            for (int m = 0; m < 4; ++m) { bf16* rowp = gates + (size_t)(row0 + ai * 128 + m * 16) * NGATE + col0;
#pragma unroll
                for (int bj = 0; bj < 2; ++bj) { const f32x4 v0 = acc[ai][bj][m][0] + bv[bj][0], v1 = acc[ai][bj][m][1] + bv[bj][1];
                    u32x4 w; w.x = pk2(sigmoidf_(v0[0]), sigmoidf_(v0[1])); w.y = pk2(sigmoidf_(v0[2]), sigmoidf_(v0[3])); w.z = pk2(sigmoidf_(v1[0]), sigmoidf_(v1[1])); w.w = pk2(sigmoidf_(v1[2]), sigmoidf_(v1[3]));
                    *(u32x4*)(rowp + bj * 128) = w; } }
    }
};
struct EpiOutProj {
    static constexpr bool PERM = true; static constexpr bool KEEPS = true;
    const unsigned char* gates; bf16* z;
    __device__ __forceinline__ void operator()(acc_t& acc, const pg8::Unit& u, int wr, int wc, int fr, int fq) const {
        const int br = u.aux, trow0 = wr * 64 + fr, tcol0 = wc * 32 + 8 * fq;
#pragma unroll
        for (int ai = 0; ai < 2; ++ai)
#pragma unroll
        for (int mh = 0; mh < 2; ++mh) {
            u32x2 g[2][2], gn[2][2];
#pragma unroll
            for (int mm = 0; mm < 2; ++mm) { const int m = 2 * mh + mm; const int tr = trow0 + ai * 128 + m * 16; const size_t grow = (size_t)(u.pm * 256 + tr);
#pragma unroll
                for (int bj = 0; bj < 2; ++bj) { const int tc = tcol0 + bj * 128;
                    const unsigned char* gp = gates + grow * NGATE + br * D + u.pn * 256 + tc;
                    g[mm][bj] = *(const u32x2*)gp;
                    gn[mm][bj] = (br < 2) ? *(const u32x2*)(gp + D) : g[mm][bj]; } }
#pragma unroll
            for (int mm = 0; mm < 2; ++mm) { const int m = 2 * mh + mm; const int tr = trow0 + ai * 128 + m * 16; const size_t grow = (size_t)(u.pm * 256 + tr);
#pragma unroll
                for (int bj = 0; bj < 2; ++bj) { const int tc = tcol0 + bj * 128; const u32x2 gg = g[mm][bj], gd = gn[mm][bj];
                    f32x4 v0 = acc[ai][bj][m][0], v1 = acc[ai][bj][m][1];
                    float f[8];
#pragma unroll
                    for (int e = 0; e < 8; ++e) { const unsigned w = e < 4 ? gg.x : gg.y, wd = e < 4 ? gd.x : gd.y; const int sh = 8 * (e & 3);
                        const float num = fmaxf((float)((w >> sh) & 255u), 1.f);
                        f[e] = (br < 2) ? num * __builtin_amdgcn_rcpf(fmaxf((float)((wd >> sh) & 255u), 1.f)) : num * (1.f / 255.f); }
                    v0[0] *= f[0]; v0[1] *= f[1]; v0[2] *= f[2]; v0[3] *= f[3]; v1[0] *= f[4]; v1[1] *= f[5]; v1[2] *= f[6]; v1[3] *= f[7];
                    if (br < 2) { acc[ai][bj][m][0] = v0; acc[ai][bj][m][1] = v1; }
                    else { u32x4 w; w.x = pk2(v0[0], v0[1]); w.y = pk2(v0[2], v0[3]); w.z = pk2(v1[0], v1[1]); w.w = pk2(v1[2], v1[3]);
                        *(u32x4*)(z + grow * D + u.pn * 256 + tc) = w; } } }
            asm volatile("" ::: "memory");
        }
    }
};
struct EpiResid {
    static constexpr bool PERM = false; static constexpr bool KEEPS = false;
    const float* x; float* hout;
    __device__ __forceinline__ void operator()(const acc_t& acc, const pg8::Unit& u, int wr, int wc, int fr, int fq) const {
        const int row0 = u.pm * 256 + wr * 64 + fr, col0 = u.pn * 256 + wc * 32 + 4 * fq;
#pragma unroll
        for (int ai = 0; ai < 2; ++ai)
#pragma unroll
            for (int m = 0; m < 4; ++m) { const size_t off = (size_t)(row0 + ai * 128 + m * 16) * D + col0;
#pragma unroll
                for (int bj = 0; bj < 2; ++bj)
#pragma unroll
                    for (int n = 0; n < 2; ++n) { const f32x4 xv = *(const f32x4*)(x + off + bj * 128 + n * 16); *(f32x4*)(hout + off + bj * 128 + n * 16) = xv + acc[ai][bj][m][n]; } }
    }
};
struct EpiSwiglu {
    static constexpr bool PERM = true; static constexpr bool KEEPS = false;
    bf16* hid;
    __device__ __forceinline__ void operator()(const acc_t& acc, const pg8::Unit& u, int wr, int wc, int fr, int fq) const {
        const int row0 = u.pm + wr * 64 + fr, col0 = u.pn * 128 + wc * 32 + 8 * fq;
#pragma unroll
        for (int ai = 0; ai < 2; ++ai)
#pragma unroll
            for (int m = 0; m < 4; ++m) { const f32x4 g0 = acc[ai][0][m][0], g1 = acc[ai][0][m][1], u0 = acc[ai][1][m][0], u1 = acc[ai][1][m][1];
                u32x4 w; w.x = pk2(siluf_(g0[0]) * u0[0], siluf_(g0[1]) * u0[1]); w.y = pk2(siluf_(g0[2]) * u0[2], siluf_(g0[3]) * u0[3]);
                w.z = pk2(siluf_(g1[0]) * u1[0], siluf_(g1[1]) * u1[1]); w.w = pk2(siluf_(g1[2]) * u1[2], siluf_(g1[3]) * u1[3]);
                *(u32x4*)(hid + (size_t)(row0 + ai * 128 + m * 16) * FF + col0) = w; }
    }
};
struct EpiDown {
    static constexpr bool PERM = true; static constexpr bool KEEPS = false;
    bf16* y; const float* ew;
    __device__ __forceinline__ void operator()(const acc_t& acc, const pg8::Unit& u, int wr, int wc, int fr, int fq) const {
        const int row0 = u.pm + wr * 64 + fr, col0 = u.pn * 256 + wc * 32 + 8 * fq;
#pragma unroll
        for (int ai = 0; ai < 2; ++ai)
#pragma unroll
            for (int m = 0; m < 4; ++m) { const int row = row0 + ai * 128 + m * 16; const float wgt = ew[row]; bf16* rowp = y + (size_t)row * D + col0;
#pragma unroll
                for (int bj = 0; bj < 2; ++bj) { const f32x4 v0 = acc[ai][bj][m][0] * wgt, v1 = acc[ai][bj][m][1] * wgt;
                    u32x4 w; w.x = pk2(v0[0], v0[1]); w.y = pk2(v0[2], v0[3]); w.z = pk2(v1[0], v1[1]); w.w = pk2(v1[2], v1[3]);
                    *(u32x4*)(rowp + bj * 128) = w; } }
    }
};

__device__ __forceinline__ float reduce16(float (&p)[16], int lane) {
#define RS_STEP(M, N) { const bool up = (lane & (M)) != 0; _Pragma("unroll") for (int i = 0; i < (N) / 2; ++i) { const float keep = up ? p[(N) / 2 + i] : p[i], send = up ? p[i] : p[(N) / 2 + i]; p[i] = keep + shx<(M)>(send); } }
    RS_STEP(32, 16) RS_STEP(16, 8) RS_STEP(8, 4) RS_STEP(4, 2)
#undef RS_STEP
    float r = p[0]; r += shx<1>(r); r += shx<2>(r); return r;
}
__device__ __forceinline__ void phase_router(const Frame& F, const float* hbuf, const float* gain) {
    LAS float* wT = (LAS float*)F.lds;
    const float* wrt = (const float*)(F.ws + WS_WRT);
    for (int i = F.tid; i < NE * D / 4; i += 512) *(LAS f32x4*)(wT + 4 * i) = *(const f32x4*)(wrt + 4 * i);
    __syncthreads();
    const int gw = F.bid * 8 + F.wave, NGW = F.G * 8, lane = F.lane;
    float* AFF = (float*)(F.ws + WS_AFF); bf16* XN = (bf16*)(F.ws + WS_XN);
    const int myexp = ((lane >> 5) & 1) * 8 + ((lane >> 4) & 1) * 4 + ((lane >> 3) & 1) * 2 + ((lane >> 2) & 1);
    for (int m = 2 * gw; m < M; m += 2 * NGW) {
        const f32x4* gr = (const f32x4*)gain + lane;
        f32x4 v[2][8]; float s[2] = {0.f, 0.f};
#pragma unroll
        for (int r = 0; r < 2; ++r) { const f32x4* xr = (const f32x4*)(hbuf + (size_t)(m + r) * D) + lane;
#pragma unroll
            for (int j = 0; j < 8; ++j) { v[r][j] = xr[64 * j]; s[r] += (v[r][j].x * v[r][j].x + v[r][j].y * v[r][j].y) + (v[r][j].z * v[r][j].z + v[r][j].w * v[r][j].w); } }
        const float rstd0 = 1.f / sqrtf(wave_sum(s[0]) * (1.f / D) + EPS), rstd1 = 1.f / sqrtf(wave_sum(s[1]) * (1.f / D) + EPS);
#pragma unroll
        for (int j = 0; j < 8; ++j) { const f32x4 g = gr[64 * j]; v[0][j] = v[0][j] * rstd0 * g; v[1][j] = v[1][j] * rstd1 * g; }
#pragma unroll
        for (int r = 0; r < 2; ++r) { u32x2* o = (u32x2*)(XN + (size_t)(m + r) * D) + lane;
#pragma unroll
            for (int j = 0; j < 8; ++j) { u32x2 w; w.x = pk2(v[r][j].x, v[r][j].y); w.y = pk2(v[r][j].z, v[r][j].w); o[64 * j] = w; } }
        float p0[16], p1[16];
#pragma unroll
        for (int e = 0; e < NE; ++e) { float a0 = 0.f, a1 = 0.f;
#pragma unroll
            for (int j = 0; j < 8; ++j) { const f32x4 w = *(LAS f32x4*)(wT + e * D + 4 * (lane + 64 * j));
                a0 += (v[0][j].x * w.x + v[0][j].y * w.y) + (v[0][j].z * w.z + v[0][j].w * w.w); a1 += (v[1][j].x * w.x + v[1][j].y * w.y) + (v[1][j].z * w.z + v[1][j].w * w.w); }
            asm volatile("" : "+v"(a0), "+v"(a1) :: "memory"); p0[e] = a0; p1[e] = a1; }
        float lg[2] = {reduce16(p0, lane), reduce16(p1, lane)};
#pragma unroll
        for (int r = 0; r < 2; ++r) {
            float mx = lg[r]; mx = fmaxf(mx, shx<4>(mx)); mx = fmaxf(mx, shx<8>(mx)); mx = fmaxf(mx, shx<16>(mx)); mx = fmaxf(mx, shx<32>(mx));
            const float ex = expf(lg[r] - mx); float den = ex; den += shx<4>(den); den += shx<8>(den); den += shx<16>(den); den += shx<32>(den);
            if ((lane & 3) == 0) AFF[(size_t)(m + r) * NE + myexp] = ex / den;
        }
    }
    __syncthreads();
}

__device__ __forceinline__ int block_excl_scan(int v, LAS int* tmp, int tid, int lane, int wave, int& total) {
    int inc = v;
#pragma unroll
    for (int o = 1; o < 64; o <<= 1) { const int t = shfl_up_i(inc, o, lane); if (lane >= o) inc += t; }
    __syncthreads();
    if (lane == 63) tmp[wave] = inc;
    __syncthreads();
    int base = 0, tot = 0;
#pragma unroll
    for (int w = 0; w < 8; ++w) { const int t = tmp[w]; if (w < wave) base += t; tot += t; }
    total = tot;
    return base + inc - v;
}
__device__ __forceinline__ void phase_topk(const Frame& F) {
    LAS int* hist = (LAS int*)F.lds;
    LAS int* tmp = (LAS int*)(F.lds + 1024);
    LAS int* bc = (LAS int*)(F.lds + 1088);
    const float* AFF = (const float*)(F.ws + WS_AFF);
    int* SEL = (int*)(F.ws + WS_SEL); int* IDX = (int*)(F.ws + WS_IDX); float* EW = (float*)(F.ws + WS_EW);
    const int tid = F.tid, lane = F.lane, wave = F.wave;
    for (int u = F.bid; u < BATCH * NE; u += F.G) {
        const int b = u >> 4, e = u & 15;
        unsigned key[8];
#pragma unroll
        for (int i = 0; i < 8; ++i) key[i] = __builtin_bit_cast(unsigned, AFF[(size_t)(b * SEQ + 8 * tid + i) * NE + e]);
        unsigned prefix = 0u, mask = 0u; int need = CAP;
        for (int pass = 3; pass >= 0; --pass) {
            __syncthreads();
            if (tid < 256) hist[tid] = 0;
            __syncthreads();
#pragma unroll
            for (int i = 0; i < 8; ++i) if ((key[i] & mask) == prefix) (void)__hip_atomic_fetch_add(&hist[(key[i] >> (8 * pass)) & 255u], 1, __ATOMIC_RELAXED, __HIP_MEMORY_SCOPE_WORKGROUP);
            __syncthreads();
            {
                const int hv = (tid < 256) ? hist[255 - tid] : 0;
                int tot_; const int above = block_excl_scan(hv, tmp, tid, lane, wave, tot_);
                if (tid < 256 && above < need && above + hv >= need) { bc[0] = 255 - tid; bc[1] = need - above; }
            }
            __syncthreads();
            prefix |= (unsigned)bc[0] << (8 * pass); mask |= 0xffu << (8 * pass); need = bc[1];
        }
        const unsigned thr = prefix;
        int neq = 0;
#pragma unroll
        for (int i = 0; i < 8; ++i) neq += (key[i] == thr);
        int tot; int eqr = block_excl_scan(neq, tmp, tid, lane, wave, tot);
        int sel[8], nsel = 0;
#pragma unroll
        for (int i = 0; i < 8; ++i) { const bool eq = key[i] == thr; sel[i] = (key[i] > thr) || (eq && eqr < need); eqr += eq; nsel += sel[i]; }
        int slot = block_excl_scan(nsel, tmp, tid, lane, wave, tot);
#pragma unroll
        for (int i = 0; i < 8; ++i) { const int t = 8 * tid + i;
            if (sel[i]) { IDX[u * CAP + slot] = t; EW[u * CAP + slot] = __builtin_bit_cast(float, key[i]); SEL[(size_t)(b * SEQ + t) * NE + e] = slot; ++slot; }
            else SEL[(size_t)(b * SEQ + t) * NE + e] = -1; }
    }
    __syncthreads();
}
__device__ __forceinline__ void phase_gather(const Frame& F) {
    const int gw = F.bid * 8 + F.wave, NGW = F.G * 8, lane = F.lane;
    const int* IDX = (const int*)(F.ws + WS_IDX); const bf16* XN = (const bf16*)(F.ws + WS_XN); bf16* XS = (bf16*)(F.ws + WS_XS);
    for (int r = gw; r < BATCH * NE * CAP; r += NGW) {
        const int b = r >> 13, t = IDX[r];
        const u32x4* src = (const u32x4*)(XN + (size_t)(b * SEQ + t) * D) + lane; u32x4* dst = (u32x4*)(XS + (size_t)r * D) + lane;
#pragma unroll
        for (int j = 0; j < 4; ++j) dst[64 * j] = src[64 * j];
    }
}
__device__ __forceinline__ void phase_combine(const Frame& F, float* hbuf, const float* next_gain) {
    const int gw = F.bid * 8 + F.wave, NGW = F.G * 8, lane = F.lane;
    const int* SEL = (const int*)(F.ws + WS_SEL); const bf16* Y = (const bf16*)(F.ws + WS_YSLOT);
    for (int m = 2 * gw; m < M; m += 2 * NGW) {
        f32x4 v[2][8]; int mysel[2];
#pragma unroll
        for (int r = 0; r < 2; ++r) { const f32x4* xr = (const f32x4*)(hbuf + (size_t)(m + r) * D) + lane;
#pragma unroll
            for (int j = 0; j < 8; ++j) v[r][j] = xr[64 * j];
            mysel[r] = (lane < NE) ? SEL[(size_t)(m + r) * NE + lane] : -1; }
        const int b = m >> 12;
        unsigned mk0 = (unsigned)(__ballot(mysel[0] >= 0) & 0xffffull), mk1 = (unsigned)(__ballot(mysel[1] >= 0) & 0xffffull);
        while (mk0 | mk1) {
            const int e0 = mk0 ? __builtin_ctz(mk0) : -1, e1 = mk1 ? __builtin_ctz(mk1) : -1;
            u32x2 y0[8], y1[8];
            if (e0 >= 0) { const int sl = __builtin_amdgcn_readlane(mysel[0], e0); const u32x2* yr = (const u32x2*)(Y + (size_t)((b * NE + e0) * CAP + sl) * D) + lane;
#pragma unroll
                for (int j = 0; j < 8; ++j) y0[j] = yr[64 * j]; }
            if (e1 >= 0) { const int sl = __builtin_amdgcn_readlane(mysel[1], e1); const u32x2* yr = (const u32x2*)(Y + (size_t)((b * NE + e1) * CAP + sl) * D) + lane;
#pragma unroll
                for (int j = 0; j < 8; ++j) y1[j] = yr[64 * j]; }
            if (e0 >= 0) {
#pragma unroll
                for (int j = 0; j < 8; ++j) { v[0][j].x += bflo(y0[j].x); v[0][j].y += bfhi(y0[j].x); v[0][j].z += bflo(y0[j].y); v[0][j].w += bfhi(y0[j].y); }
                mk0 &= mk0 - 1; }
            if (e1 >= 0) {
#pragma unroll
                for (int j = 0; j < 8; ++j) { v[1][j].x += bflo(y1[j].x); v[1][j].y += bfhi(y1[j].x); v[1][j].z += bflo(y1[j].y); v[1][j].w += bfhi(y1[j].y); }
                mk1 &= mk1 - 1; }
        }
#pragma unroll
        for (int r = 0; r < 2; ++r) { f32x4* xr = (f32x4*)(hbuf + (size_t)(m + r) * D) + lane;
#pragma unroll
            for (int j = 0; j < 8; ++j) xr[64 * j] = v[r][j]; }
        if (next_gain) {
            const f32x4* gr = (const f32x4*)next_gain + lane;
#pragma unroll
            for (int r = 0; r < 2; ++r) {
                float s = 0.f;
#pragma unroll
                for (int j = 0; j < 8; ++j) s += (v[r][j].x * v[r][j].x + v[r][j].y * v[r][j].y) + (v[r][j].z * v[r][j].z + v[r][j].w * v[r][j].w);
                const float rstd = 1.f / sqrtf(wave_sum(s) * (1.f / D) + EPS);
                u32x2* o = (u32x2*)((bf16*)(F.ws + WS_XN) + (size_t)(m + r) * D) + lane;
#pragma unroll
                for (int j = 0; j < 8; ++j) { const f32x4 g = gr[64 * j]; u32x2 w; w.x = pk2(v[r][j].x * rstd * g.x, v[r][j].y * rstd * g.y); w.y = pk2(v[r][j].z * rstd * g.z, v[r][j].w * rstd * g.w); o[64 * j] = w; }
            }
        }
    }
}

constexpr int NPH = 14;
template <int PSEL>
__device__ __forceinline__ void layer_body(Frame& F, const ArgsP kp, const int l) {
#define SEAM(k) do { if (PSEL < 0) { ArgsP A_ = kp; asm volatile("" : "+s"(A_)); LAS unsigned char* l_ = F.lds; asm volatile("" : "+s"(l_)); int w_ = F.wave; asm volatile("" : "+s"(w_)); int t_; asm volatile("v_mbcnt_lo_u32_b32 %0, -1, 0\n\tv_mbcnt_hi_u32_b32 %0, -1, %0" : "=v"(t_)); t_ += w_ * 64; \
        XcdBarrier b_; b_.bar = (unsigned*)(A_->ws + WS_CTL) + CW_BAR; b_.x = xb_xcc_id(); b_.st = (volatile LAS unsigned*)(l_ + MISC_OFF) + 8; xcd_barrier(b_, t_); } } while (0)
#ifndef PH_MASK
#define PH_MASK 0x3fff
#endif
#define IN(p) (((PH_MASK >> (p)) & 1) && (PSEL < 0 || PSEL == (p)))
#define PHASE_BEGIN() ArgsP A = kp; asm volatile("" : "+s"(A)); unsigned char* ws = A->ws; F.ws = ws; F.ctl = (unsigned*)(ws + WS_CTL); \
        { LAS unsigned char* l_ = F.lds; asm volatile("" : "+s"(l_)); F.lds = l_; } \
        { int w_ = F.wave; asm volatile("" : "+s"(w_)); int ln_; asm volatile("v_mbcnt_lo_u32_b32 %0, -1, 0\n\tv_mbcnt_hi_u32_b32 %0, -1, %0" : "=v"(ln_)); F.wave = w_; F.lane = ln_; F.tid = w_ * 64 + ln_; } \
        { int b_ = F.bid, g_ = F.G; asm volatile("" : "+s"(b_), "+s"(g_)); F.bid = b_; F.G = g_; }
        if (l == 0) {
        if (IN(0)) { PHASE_BEGIN(); phase_convert(F, A, l); phase_rms_x(F, (const float*)A->in[0], (const float*)A->in[2]); __syncthreads(); }
        SEAM(0);
        if (DBL == 0) { { PHASE_BEGIN(); phase_convert(F, A, l); phase_rms_x(F, (const float*)A->in[0], (const float*)A->in[2]); __syncthreads(); } SEAM(0); }
        }
        for (int rep_ = 0; rep_ < (DBL == 1 ? 2 : 1); ++rep_) {
        if (rep_) SEAM(1);
        if (IN(1)) { PHASE_BEGIN();
            SchedPlain S{(const char*)(ws + WS_XN), (const char*)(ws + WS_W1T), D, D, 64, 52, 32, F.G, F.bid};
            EpiProj E{(bf16*)(ws + WS_PROJ), (float*)(ws + WS_SCAL), (unsigned char*)(ws + WS_GATES), (const float*)A->in[22] + (size_t)l * NGATE};
            pg8::gemm_phase(F.lds, F.tid, D, D, S, E);
        }
        }
        SEAM(1);
        if (IN(2)) { PHASE_BEGIN(); phase_prep(F, A, l); }
        SEAM(2);
        if (DBL == 2) { { PHASE_BEGIN(); phase_prep(F, A, l); } SEAM(2); }
        for (int rep3 = 0; rep3 < (DBL == 33 ? 2 : 1); ++rep3) {
        if (rep3) SEAM(3);
        if (IN(3)) {
            { PHASE_BEGIN();
#ifndef NO_SCAN
            if (F.bid < 48 && (rep3 == 0 || (DBL3MASK & 1))) scan_chain_wg(F, F.bid);
#endif
            __syncthreads(); }
            if (DBL == 31) { PHASE_BEGIN(); if (F.bid < 48) scan_chain_wg(F, F.bid); __syncthreads(); }
            if (DBL >= 30) SEAM(3);
            { PHASE_BEGIN();
              if (F.bid >= 192 && (rep3 == 0 || (DBL3MASK & 2))) for (;;) {
                volatile LAS unsigned* MQ = (volatile LAS unsigned*)(F.lds + MISC_OFF);
                if (F.tid == 0) MQ[0] = __hip_atomic_fetch_add(F.ctl + CW_Q + 64 * (4 + l + 8 * rep3), 1u, RLX_AGENT);
                __syncthreads();
                const int u = (int)MQ[0];
                __syncthreads();
                if (u >= N_CVT_UNITS) break;
                convert_expert_unit(F, A, l, u);
              } }
            for (int rep = 0; rep < (DBL == 32 ? 2 : 1); ++rep) {
            PHASE_BEGIN();
            const float* qn = (const float*)A->in[5] + l * 64; const float* kn = (const float*)A->in[6] + l * 64;
            const float* lq1 = (const float*)A->in[7] + l * 64; const float* lk1 = (const float*)A->in[8] + l * 64;
            const float* lq2 = (const float*)A->in[9] + l * 64; const float* lk2 = (const float*)A->in[10] + l * 64;
            float d1 = 0.f, d2 = 0.f, gq = 0.f, gk = 0.f;
            for (int i = 0; i < 64; ++i) { d1 += lq1[i] * lk1[i]; d2 += lq2[i] * lk2[i]; gq = fmaxf(gq, fabsf(qn[i])); gk = fmaxf(gk, fabsf(kn[i])); }
            const float lam_init = 0.8f - 0.6f * expf(-0.3f * (float)l);
            const float lam = expf(d1) - expf(d2) + lam_init;
            const float negM2 = -(8.f * gq * gk * 1.4426950408889634f);
            const float* subln = (const float*)A->in[11] + l * 128;
            if (rep3 == 0 || (DBL3MASK & 4)) {
              const int xq = (int)(xb_xcc_id() & 7u);
#pragma unroll 1
              for (int kq = 0; kq < 8; ++kq) {
                const int q = (xq + kq) & 7;
                for (;;) {
                    volatile LAS unsigned* MQ = (volatile LAS unsigned*)(F.lds + MISC_OFF);
                    if (F.tid == 0) MQ[0] = __hip_atomic_fetch_add(F.ctl + CW_Q + 64 * (32 + ((l * 2 + rep) * 2 + rep3) * 8 + q), 1u, RLX_AGENT);
                    __syncthreads();
                    const int u = (int)MQ[0];
                    __syncthreads();
                    if (u >= 3 * 32) break;
                    const int bh = q + 8 * (u >> 5), qb = u & 31;
#ifndef NO_ATTN
                    attn_unit(F, bh / HB, bh % HB, qb, lam, negM2, subln, 1.f - lam_init);
#endif
                }
              }
            }
            if (DBL == 32 && rep == 0) SEAM(3);
            }
            { PHASE_BEGIN();
              if (F.bid < 192 && (rep3 == 0 || (DBL3MASK & 2))) for (;;) {
                volatile LAS unsigned* MQ = (volatile LAS unsigned*)(F.lds + MISC_OFF);
                if (F.tid == 0) MQ[0] = __hip_atomic_fetch_add(F.ctl + CW_Q + 64 * (4 + l + 8 * rep3), 1u, RLX_AGENT);
                __syncthreads();
                const int u = (int)MQ[0];
                __syncthreads();
                if (u >= N_CVT_UNITS) break;
                convert_expert_unit(F, A, l, u);
              } }
        }
        }
        SEAM(3);
        if (IN(4)) { PHASE_BEGIN(); phase_delta_fin(F, (const float*)A->in[17] + l * 128); }
        SEAM(4);
        for (int rep_ = 0; rep_ < (DBL == 6 ? 2 : 1); ++rep_) {
        if (rep_) SEAM(6);
        if (IN(6)) { PHASE_BEGIN();
            SchedOutProj S{(const char*)(ws + WS_MMIX), (const char*)(ws + WS_WOUTT), F.G, F.bid};
            EpiOutProj E{(const unsigned char*)(ws + WS_GATES), (bf16*)(ws + WS_Z)};
            pg8::gemm_phase(F.lds, F.tid, D, D, S, E);
        }
        }
        SEAM(6);
        if (IN(7)) { PHASE_BEGIN();
            SchedPlain S{(const char*)(ws + WS_Z), (const char*)(ws + WS_WOT), D, D, 64, 8, 32, F.G, F.bid};
            EpiResid E{(l == 0) ? (const float*)A->in[0] : (const float*)A->out, A->out};
            pg8::gemm_phase(F.lds, F.tid, D, D, S, E);
        }
        SEAM(7);
        if (IN(8)) { PHASE_BEGIN(); phase_router(F, A->out, (const float*)A->in[24] + (size_t)l * D); }
        SEAM(8);
        if (IN(9)) { PHASE_BEGIN(); phase_topk(F); }
        SEAM(9);
        for (int rep_ = 0; rep_ < (DBL == 11 ? 2 : 1); ++rep_) {
        if (rep_) SEAM(11);
        if (IN(11)) { PHASE_BEGIN();
            SchedExpertGather S{(const char*)(ws + WS_XN), (const char*)(ws + WS_WGU), (const int*)(ws + WS_IDX), D, 32, F.G, F.bid};
            EpiSwiglu E{(bf16*)(ws + WS_HID)};
            pg8::gemm_phase<EpiSwiglu, SchedExpertGather, true>(F.lds, F.tid, D, D, S, E);
        }
        }
        SEAM(11);
        for (int rep_ = 0; rep_ < (DBL == 12 ? 2 : 1); ++rep_) {
        if (rep_) SEAM(12);
        if (IN(12)) { PHASE_BEGIN();
            SchedExpert S{(const char*)(ws + WS_HID), (const char*)(ws + WS_WDN), FF, FF, 16, F.G, F.bid};
            EpiDown E{(bf16*)(ws + WS_YSLOT), (const float*)(ws + WS_EW)};
            pg8::gemm_phase(F.lds, F.tid, FF, FF, S, E);
        }
        }
        SEAM(12);
        if (IN(13)) { PHASE_BEGIN(); phase_combine(F, A->out, (l + 1 < DEPTH) ? (const float*)A->in[2] + (size_t)(l + 1) * D : nullptr); if (l + 1 < DEPTH) { __syncthreads(); phase_convert(F, A, l + 1); __syncthreads(); } }
        if (l + 1 < DEPTH) SEAM(13);
#undef IN
#undef SEAM
#undef PHASE_BEGIN
}
template <int PSEL>
__global__ void __launch_bounds__(512, 2) fwd_kernel(Args args_unused) {
    extern __shared__ __attribute__((aligned(16))) unsigned char lds_raw[];
    const ArgsP kp = (ArgsP)__builtin_amdgcn_kernarg_segment_ptr();
    Frame F;
    F.lds = (LAS unsigned char*)lds_raw; F.ws = kp->ws; F.ctl = (unsigned*)(kp->ws + WS_CTL);
    F.tid = threadIdx.x; F.lane = F.tid & 63; F.wave = __builtin_amdgcn_readfirstlane(F.tid >> 6); F.bid = blockIdx.x; F.G = gridDim.x;
    volatile LAS unsigned* MISC = (volatile LAS unsigned*)(F.lds + MISC_OFF);
    if (F.tid < 32) MISC[F.tid] = 0u;
    __syncthreads();
    if (PSEL < 0) (void)xcd_barrier_post(F.ctl + CW_BAR, MISC + 8, F.tid);
    if (PSEL < 0) { layer_body<PSEL>(F, kp, 0); layer_body<PSEL>(F, kp, 1); }
    else layer_body<PSEL>(F, kp, kp->ph_lo);
}

static hipError_t set_lds_attr() {
    hipError_t e = hipSuccess;
#if MK_ONE_LAUNCH
    e = hipFuncSetAttribute((const void*)fwd_kernel<-1>, hipFuncAttributeMaxDynamicSharedMemorySize, LDS_BYTES);
#else
#define SA(p) if (e == hipSuccess) e = hipFuncSetAttribute((const void*)fwd_kernel<p>, hipFuncAttributeMaxDynamicSharedMemorySize, LDS_BYTES);
    SA(0) SA(1) SA(2) SA(3) SA(4) SA(5) SA(6) SA(7) SA(8) SA(9) SA(10) SA(11) SA(12) SA(13)
#undef SA
#endif
    return e;
}
extern "C" void kernel_launch(void* const* d_in, const int* in_sizes, int n_in, void* d_out, int out_size, void* d_ws, size_t ws_size, hipStream_t stream) {
    static int grid = 0;
    if (grid == 0) {
        if (n_in != 29 || out_size != M * D || ws_size < WS_END) { fprintf(stderr, "kernel_launch: unexpected shapes: n_in %d out %d ws %zu (need %zu)\n", n_in, out_size, ws_size, (size_t)WS_END); grid = -1; return; }
        int dev = 0, cus = 0;
        if (hipGetDevice(&dev) != hipSuccess || hipDeviceGetAttribute(&cus, hipDeviceAttributeMultiprocessorCount, dev) != hipSuccess) { grid = -1; return; }
        if (set_lds_attr() != hipSuccess) { fprintf(stderr, "kernel_launch: hipFuncSetAttribute failed\n"); grid = -1; return; }
        (void)hipGetLastError();
        grid = cus < 256 ? cus : 256;
    }
    if (grid < 0) return;
    (void)hipMemsetAsync((char*)d_ws + WS_CTL, 0, CTL_ZERO_BYTES, stream);
    Args a{};
    for (int i = 0; i < 29; ++i) a.in[i] = d_in[i];
    a.out = (float*)d_out; a.ws = (unsigned char*)d_ws;
#if MK_ONE_LAUNCH
    a.ph_lo = 0; a.ph_hi = DEPTH;
    hipLaunchKernelGGL(fwd_kernel<-1>, dim3(grid), dim3(512), LDS_BYTES, stream, a);
#else
    for (int l = 0; l < DEPTH; ++l) { a.ph_lo = l; a.ph_hi = l + 1;
#define LP(p) hipLaunchKernelGGL(fwd_kernel<p>, dim3(grid), dim3(512), LDS_BYTES, stream, a);
        LP(0) LP(1) LP(2) LP(3) LP(4) LP(5) LP(6) LP(7) LP(8) LP(9) LP(10) LP(11) LP(12) LP(13)
#undef LP
    }
#endif
}
```

```cpp
#include <hip/hip_runtime.h>
#include <cstdio>
#include <cstdint>
#include <cmath>

#ifndef DBLP
#define DBLP 0
#endif
#ifndef DBL3MASK
#define DBL3MASK 7
#endif
#ifndef DBL
#define DBL -1
#endif
#ifndef MK_ONE_LAUNCH
#define MK_ONE_LAUNCH 1
#endif

#define LAS __attribute__((address_space(3)))
#define GAS __attribute__((address_space(1)))
typedef unsigned short bf16;
typedef short bf16x8 __attribute__((ext_vector_type(8)));
typedef short s16x4 __attribute__((ext_vector_type(4)));
typedef float f32x4 __attribute__((ext_vector_type(4)));
typedef float f32x2 __attribute__((ext_vector_type(2)));
typedef float f32x16 __attribute__((ext_vector_type(16)));
typedef unsigned u32x4 __attribute__((ext_vector_type(4)));
typedef unsigned u32x2 __attribute__((ext_vector_type(2)));
typedef __bf16 bf16x2_t __attribute__((ext_vector_type(2)));

constexpr int D = 2048, BATCH = 4, SEQ = 4096, M = BATCH * SEQ, DEPTH = 2;
constexpr int NIN = 6936, NPROJ = 6912, NGATE = 6144, NPROJ_PAD = 7168;
constexpr int WA = 512, WB = 768, WC = 768, HB = 6, HC = 6;
constexpr int NE = 16, CAP = 512, FF = 1024;
constexpr float EPS = 1e-6f;
constexpr int PC_BA = 0, PC_CA = 512, PC_VA = 1024, PC_QB = 1536, PC_KB = 2304, PC_VB = 3072, PC_QC = 3840, PC_KC = 4608, PC_VC = 5376, PC_GC = 6144;
constexpr int NCHUNK = SEQ / 64;

__device__ __forceinline__ unsigned f2bf(float f) { unsigned u = __builtin_bit_cast(unsigned, f); return (u + 0x7fffu + ((u >> 16) & 1u)) >> 16; }
__device__ __forceinline__ unsigned pk2(float lo, float hi) { f32x2 v = {lo, hi}; bf16x2_t b = __builtin_convertvector(v, bf16x2_t); return __builtin_bit_cast(unsigned, b); }
__device__ __forceinline__ float bf2f(unsigned short h) { return __builtin_bit_cast(float, (unsigned)h << 16); }
__device__ __forceinline__ float bflo(unsigned w) { return __builtin_bit_cast(float, w << 16); }
__device__ __forceinline__ float bfhi(unsigned w) { return __builtin_bit_cast(float, w & 0xffff0000u); }
__device__ __forceinline__ float sigmoidf_(float x) { return __builtin_amdgcn_rcpf(1.f + __builtin_amdgcn_exp2f(-1.4426950408889634f * x)); }
__device__ __forceinline__ float siluf_(float x) { return x * __builtin_amdgcn_rcpf(1.f + __builtin_amdgcn_exp2f(-1.4426950408889634f * x)); }
template <int O> __device__ __forceinline__ float shx(float v) {
    if constexpr (O < 32) return __builtin_bit_cast(float, __builtin_amdgcn_ds_swizzle(__builtin_bit_cast(int, v), (O << 10) | 0x1f));
    else { const unsigned u = __builtin_bit_cast(unsigned, v); auto rr = __builtin_amdgcn_permlane32_swap(u, u, false, false);
        const unsigned a = rr[0], b = rr[1]; return __builtin_bit_cast(float, a == u ? b : a); }
}
__device__ __forceinline__ float wave_sum(float v) {
    v += shx<1>(v); v += shx<2>(v); v += shx<4>(v); v += shx<8>(v); v += shx<16>(v);
    const unsigned u = __builtin_bit_cast(unsigned, v); auto rr = __builtin_amdgcn_permlane32_swap(u, u, false, false);
    return __builtin_bit_cast(float, (unsigned)rr[0]) + __builtin_bit_cast(float, (unsigned)rr[1]);
}
__device__ __forceinline__ float shfl_up_f(float v, int o, int lane) { return __builtin_bit_cast(float, __builtin_amdgcn_ds_bpermute(((lane - o) & 63) << 2, __builtin_bit_cast(int, v))); }
__device__ __forceinline__ int shfl_up_i(int v, int o, int lane) { return __builtin_amdgcn_ds_bpermute(((lane - o) & 63) << 2, v); }
#define LDS_WAIT() asm volatile("s_waitcnt lgkmcnt(0)" ::: "memory")
#define LBAR() do { asm volatile("s_waitcnt lgkmcnt(0)" ::: "memory"); __builtin_amdgcn_s_barrier(); asm volatile("" ::: "memory"); } while (0)
#define VM_WAIT() asm volatile("s_waitcnt vmcnt(0)" ::: "memory")

namespace pg8 {
constexpr int BM = 256, BK = 64, HALF = 128, HTB = HALF * BK * 2, STAGE_BYTES = 8 * HTB;
__host__ __device__ __forceinline__ int lds_byte(int r, int c) { const int st = (r >> 4) * 2 + (c >> 5), rr = r & 15, cc = c & 31, ob = rr * 64 + cc * 2; return st * 1024 + (ob ^ (((ob >> 9) & 1) << 5)); }
__host__ __device__ __forceinline__ void stage_rc(int b, int& R, int& C) { const int st = b / 1024, sb = b % 1024, swz = sb ^ (((sb >> 9) & 1) << 5); R = (st >> 1) * 16 + swz / 64; C = (st & 1) * 32 + (swz % 64) / 2; }
__host__ __device__ __forceinline__ int perm32(int rho) { const int n = rho >> 4, i = rho & 15; return 8 * (i >> 2) + 4 * n + (i & 3); }

struct Unit { const char* a; const char* b; int nt; int pm, pn, aux; };

template <class Epi, class Sched, bool GATHER = false>
__device__ __forceinline__ void gemm_phase(LAS unsigned char* lds, const int tid, const int lda, const int ldb, const Sched& S, const Epi& E) {
    const int wid = __builtin_amdgcn_readfirstlane(tid >> 6), lane = tid & 63, wr = wid >> 2, wc = wid & 3, fr = lane & 15, fq = lane >> 4;
    unsigned voffA[2], voffB[2];
#pragma unroll
    for (int i = 0; i < 2; ++i) { int R, C; stage_rc(tid * 16 + i * 8192, R, C); const int Rb = Epi::PERM ? ((R & ~31) + perm32(R & 31)) : R;
        voffA[i] = (unsigned)(R * lda + C) * 2u; voffB[i] = (unsigned)(Rb * ldb + C) * 2u; }
    const size_t kstep = (size_t)(BK * 2);
    const size_t hstepA = (size_t)HALF * lda * 2, hstepB = (size_t)HALF * ldb * 2;
    const unsigned ldsw = (unsigned)wid * 1024u;
    const int aoff = lds_byte(wr * 64 + fr, fq * 8), boff = lds_byte(wc * 32 + fr, fq * 8);
#define PG8_SA(b, h) (((b) * 2 + (h)) * HTB)
#define PG8_SB(b, h) ((4 + (b) * 2 + (h)) * HTB)
#define PG8_STAGE(bufoff, gbase, voff) do { _Pragma("unroll") for (int _i = 0; _i < 2; ++_i) \
        __builtin_amdgcn_global_load_lds((const unsigned*)((const char*)(gbase) + (voff)[_i]), (LAS unsigned*)(lds + (bufoff) + ldsw + _i * 8192), 16, 0, 0); } while (0)
#define PG8_LDA(dst, b, h) do { _Pragma("unroll") for (int m = 0; m < 4; ++m) _Pragma("unroll") for (int k = 0; k < 2; ++k) dst[m][k] = *(const LAS bf16x8*)(lds + PG8_SA(b, h) + aoff + m * 2048 + k * 1024); } while (0)
#define PG8_LDB(dst, b, h) do { _Pragma("unroll") for (int n = 0; n < 2; ++n) _Pragma("unroll") for (int k = 0; k < 2; ++k) dst[n][k] = *(const LAS bf16x8*)(lds + PG8_SB(b, h) + boff + n * 2048 + k * 1024); } while (0)
#define PG8_MMA(ai, bj, At, Bt) do { __builtin_amdgcn_s_setprio(1); _Pragma("unroll") for (int m = 0; m < 4; ++m) _Pragma("unroll") for (int n = 0; n < 2; ++n) _Pragma("unroll") for (int k = 0; k < 2; ++k) \
        acc[ai][bj][m][n] = __builtin_amdgcn_mfma_f32_16x16x32_bf16(Bt[n][k], At[m][k], acc[ai][bj][m][n], 0, 0, 0); __builtin_amdgcn_s_setprio(0); } while (0)
#define PG8_WAIT_V(n) asm volatile("s_waitcnt vmcnt(" #n ")" ::: "memory")
#define PG8_WAIT_L(n) asm volatile("s_waitcnt lgkmcnt(" #n ")" ::: "memory")
#define PG8_BAR __builtin_amdgcn_s_barrier()
#define PG8_SCHED __builtin_amdgcn_sched_barrier(0)
    Unit cur, nxt; int ui = 0;
    if (!S.next(0, cur)) return;
    f32x4 acc[2][2][4][2];
#pragma unroll
    for (int a = 0; a < 2; ++a)
#pragma unroll
        for (int b = 0; b < 2; ++b)
#pragma unroll
            for (int m = 0; m < 4; ++m)
#pragma unroll
                for (int n = 0; n < 2; ++n) acc[a][b][m][n] = (f32x4){0.f, 0.f, 0.f, 0.f};
    bf16x8 At[4][2], B0[2][2], B1[2][2];
    const char* cA = cur.a; const char* cB = cur.b;
    unsigned cv[2][2], nv[2][2];
#pragma unroll
    for (int i = 0; i < 2; ++i) { cv[0][i] = voffA[i]; cv[1][i] = voffA[i] + (unsigned)hstepA; nv[0][i] = cv[0][i]; nv[1][i] = cv[1][i]; }
    auto gather_offs = [&](const Unit& u, unsigned (&v)[2][2]) {
#pragma unroll
        for (int h = 0; h < 2; ++h)
#pragma unroll
            for (int i = 0; i < 2; ++i) { int R, C; stage_rc(tid * 16 + i * 8192, R, C); v[h][i] = (unsigned)(S.row_index(u, h * HALF + R) * lda + C) * 2u; } };
    if constexpr (GATHER) { gather_offs(cur, cv); }
    PG8_STAGE(PG8_SB(0, 0), cB, voffB); PG8_STAGE(PG8_SB(0, 1), cB + hstepB, voffB); PG8_STAGE(PG8_SA(0, 0), cA, cv[0]); PG8_STAGE(PG8_SA(0, 1), cA, cv[1]);
    if (wr == 1) PG8_BAR;
    PG8_WAIT_V(2); PG8_BAR;
    PG8_STAGE(PG8_SB(1, 0), cB + kstep, voffB); PG8_STAGE(PG8_SA(1, 0), cA + kstep, cv[0]); PG8_STAGE(PG8_SB(1, 1), cB + hstepB + kstep, voffB);
    PG8_WAIT_V(6); PG8_BAR;
    for (;;) {
        const bool has_next = S.next(ui + 1, nxt);
        const char* nA = has_next ? nxt.a : cA; const char* nB = has_next ? nxt.b : cB;
        if constexpr (GATHER) { if (has_next) gather_offs(nxt, nv); else {
#pragma unroll
            for (int h = 0; h < 2; ++h)
#pragma unroll
                for (int i = 0; i < 2; ++i) nv[h][i] = cv[h][i]; } }
        const int nt = cur.nt;
        for (int t = 0; t < nt; t += 2) {
            const bool last = (t == nt - 2);
            const char* a1 = cA + (size_t)(t + 1) * kstep;
            const char* a2 = last ? nA : cA + (size_t)(t + 2) * kstep; const char* b2 = last ? nB : cB + (size_t)(t + 2) * kstep;
            const char* a3 = a2 + kstep; const char* b3 = b2 + kstep;
            unsigned s0[2], s1[2];
#pragma unroll
            for (int i = 0; i < 2; ++i) { s0[i] = (GATHER && last) ? nv[0][i] : cv[0][i]; s1[i] = (GATHER && last) ? nv[1][i] : cv[1][i]; }
            PG8_LDB(B0, 0, 0); PG8_LDB(B1, 0, 1); PG8_SCHED; PG8_LDA(At, 0, 0); PG8_STAGE(PG8_SA(1, 1), a1, cv[1]);
            PG8_WAIT_V(8); PG8_WAIT_L(0); PG8_BAR; PG8_MMA(0, 0, At, B0); PG8_MMA(0, 1, At, B1); PG8_BAR; PG8_SCHED;
            PG8_LDA(At, 0, 1); PG8_STAGE(PG8_SB(0, 0), b2, voffB); PG8_STAGE(PG8_SB(0, 1), b2 + hstepB, voffB); PG8_STAGE(PG8_SA(0, 0), a2, s0);
            PG8_WAIT_V(8); PG8_WAIT_L(0); PG8_BAR; PG8_MMA(1, 0, At, B0); PG8_MMA(1, 1, At, B1); PG8_BAR; PG8_SCHED;
            PG8_LDB(B0, 1, 0); PG8_LDB(B1, 1, 1); PG8_SCHED; PG8_LDA(At, 1, 0); PG8_STAGE(PG8_SA(0, 1), a2, s1);
            PG8_WAIT_V(8); PG8_WAIT_L(0); PG8_BAR; PG8_MMA(0, 0, At, B0); PG8_MMA(0, 1, At, B1); PG8_BAR; PG8_SCHED;
            PG8_LDA(At, 1, 1); PG8_STAGE(PG8_SB(1, 0), b3, voffB); PG8_STAGE(PG8_SB(1, 1), b3 + hstepB, voffB); PG8_STAGE(PG8_SA(1, 0), a3, s0);
            PG8_WAIT_V(8); PG8_WAIT_L(0); PG8_BAR; PG8_MMA(1, 0, At, B0); PG8_MMA(1, 1, At, B1); PG8_BAR; PG8_SCHED;
        }
        if (wr == 0) PG8_BAR;
        E(acc, cur, wr, wc, fr, fq);
        if (!has_next) break;
        if (!(Epi::KEEPS && cur.aux < 2)) {
#pragma unroll
        for (int a = 0; a < 2; ++a)
#pragma unroll
            for (int b = 0; b < 2; ++b)
#pragma unroll
                for (int m = 0; m < 4; ++m)
#pragma unroll
                    for (int n = 0; n < 2; ++n) acc[a][b][m][n] = (f32x4){0.f, 0.f, 0.f, 0.f};
        }
        cur = nxt; cA = nA; cB = nB; ++ui;
        if constexpr (GATHER) {
#pragma unroll
            for (int h = 0; h < 2; ++h)
#pragma unroll
                for (int i = 0; i < 2; ++i) cv[h][i] = nv[h][i]; }
        if (wr == 1) PG8_BAR;
    }
    PG8_WAIT_V(0);
    PG8_BAR;
#undef PG8_SA
#undef PG8_SB
#undef PG8_STAGE
#undef PG8_LDA
#undef PG8_LDB
#undef PG8_MMA
#undef PG8_WAIT_V
#undef PG8_WAIT_L
#undef PG8_BAR
#undef PG8_SCHED
}
}

constexpr size_t MiB = 1u << 20;
constexpr size_t WS_CTL = 0, CTL_ZERO_BYTES = 1 * MiB;
constexpr size_t WS_W1T = 1 * MiB;
constexpr size_t WS_WGT = 29 * MiB;
constexpr size_t WS_WOUTT = 53 * MiB;
constexpr size_t WS_WOT = 61 * MiB;
constexpr size_t WS_WGU = 69 * MiB;
constexpr size_t WS_WDN = 197 * MiB;
constexpr size_t WS_WRT = 261 * MiB;
constexpr size_t WS_XN = 262 * MiB;
constexpr size_t WS_PROJ = 326 * MiB;
constexpr size_t WS_HID = WS_PROJ;
constexpr size_t WS_YSLOT = WS_PROJ + 64 * MiB;
constexpr size_t WS_SCAL = 542 * MiB;
constexpr size_t WS_MMIX = 544 * MiB;
constexpr size_t WS_QKB = 608 * MiB;
constexpr size_t WS_SCANOP = 656 * MiB;
constexpr size_t WS_Z = WS_SCANOP;
constexpr size_t WS_ZACC = WS_SCANOP + 64 * MiB;
constexpr size_t WS_XS = WS_SCANOP;
constexpr size_t WS_OF = 872 * MiB;
constexpr size_t WS_OB = 920 * MiB;
constexpr size_t WS_AFF = 968 * MiB;
constexpr size_t WS_SEL = 969 * MiB;
constexpr size_t WS_IDX = 970 * MiB;
constexpr size_t WS_EW = 970 * MiB + 512 * 1024;
constexpr size_t WS_GATES = 972 * MiB;
constexpr size_t WS_END = 1164 * MiB;
static_assert(WS_WGT == WS_W1T + (size_t)NPROJ_PAD * D * 2, "W_in^T and W_gate^T form one [13312][2048] B matrix");
constexpr int SCANOP_BYTES = 73728;
constexpr int SO_W = 0, SO_Q = 16384, SO_K = 32768, SO_A = 49152, SO_U = 57344;
constexpr int CW_TMO = 0, CW_BAR = 4096, CW_Q = 8192;

constexpr int LDS_BYTES = 163840, MISC_OFF = 163584;
static_assert(pg8::STAGE_BYTES <= MISC_OFF, "lds");

#define RLX_AGENT __ATOMIC_RELAXED, __HIP_MEMORY_SCOPE_AGENT
#define XB_TMO      128
#define XB_XCNT(j)  (256  + 64 * (j))
#define XB_XSUB(j)  (1280 + 64 * (j))
#define XB_XGEN(j)  (2304 + 64 * (j))
#define XB_TOP      3328
#define XB_TOPGEN   3392
#define XCD_BAR_WORDS 3456
#define XB_SPIN_CAP (1u << 18)
__device__ __forceinline__ unsigned xb_ld(unsigned* p)              { return __hip_atomic_load(p, __ATOMIC_RELAXED, __HIP_MEMORY_SCOPE_AGENT); }
__device__ __forceinline__ unsigned xb_add(unsigned* p, unsigned v) { return __hip_atomic_fetch_add(p, v, __ATOMIC_RELAXED, __HIP_MEMORY_SCOPE_AGENT); }
__device__ __forceinline__ unsigned xb_xcc_id() { return (unsigned)__builtin_amdgcn_s_getreg((3 << 11) | 20) & 0xFu; }
#define XB_SPIN(cond, bar) do { unsigned _sp = 0; while (cond) { __builtin_amdgcn_s_sleep(1); \
    if ((++_sp & 255u) == 0u) { if (xb_ld(&(bar)[XB_TMO])) break; if (_sp > XB_SPIN_CAP) { atomicAdd(&(bar)[XB_TMO], 1u); break; } } } } while (0)
struct XcdBarrier { unsigned* bar; unsigned x; volatile LAS unsigned* st; };
__device__ __forceinline__ XcdBarrier xcd_barrier_post(unsigned* bar, volatile LAS unsigned* st, int tid) {
    XcdBarrier b; b.bar = bar; b.x = xb_xcc_id(); b.st = st;
    if (tid == 0) (void)xb_add(&bar[XB_XCNT(b.x)], 1u);
    return b;
}
__device__ __forceinline__ void xcd_barrier_complete(unsigned* bar, unsigned x, unsigned& nloc, unsigned& nx) {
    const unsigned G = gridDim.x * gridDim.y * gridDim.z;
    unsigned sum, cnt, mine, sp = 0u;
    for (;;) {
        sum = 0u; cnt = 0u; mine = 0u;
#pragma unroll 1
        for (unsigned j = 0; j < 16; ++j) { const unsigned c = xb_ld(&bar[XB_XCNT(j)]); sum += c; cnt += (c > 0u) ? 1u : 0u; mine = (j == x) ? c : mine; }
        if (sum == G) break;
        __builtin_amdgcn_s_sleep(1);
        if ((++sp & 255u) == 0u) { if (xb_ld(&bar[XB_TMO])) break; if (sp > XB_SPIN_CAP) { atomicAdd(&bar[XB_TMO], 1u); break; } }
    }
    nloc = mine > 0u ? mine : 1u; nx = cnt > 0u ? cnt : 1u;
}
__device__ __forceinline__ void xcd_barrier(const XcdBarrier& b, int tid) {
    asm volatile("s_waitcnt vmcnt(0)" ::: "memory");
    __syncthreads();
    f32x4 pf0_ = {0.f, 0.f, 0.f, 0.f}, pf1_ = pf0_;
    const bool pfw_ = tid >= 64;
    if (pfw_) { unsigned long long pc_; asm volatile("s_getpc_b64 %0" : "=s"(pc_));
        const unsigned long long lim_ = ((unsigned long long)b.st[13] << 32) | (unsigned long long)b.st[12], base_ = pc_ & ~0xFFull;
        const unsigned long long a0_ = base_ + (unsigned long long)(tid - 64) * 16ull, a1_ = a0_ + 7168ull;
        const unsigned long long s0_ = (a0_ + 16ull <= lim_) ? a0_ : base_, s1_ = (a1_ + 16ull <= lim_) ? a1_ : base_;
        asm volatile("global_load_dwordx4 %0, %2, off\n\tglobal_load_dwordx4 %1, %3, off" : "=&v"(pf0_), "=&v"(pf1_) : "v"(s0_), "v"(s1_) : "memory"); }
    if (tid == 0) {
        unsigned* bar = b.bar;
        __builtin_amdgcn_s_waitcnt(0);
        unsigned nloc = b.st[0], nx = b.st[1];
        if (nloc == 0u) { xcd_barrier_complete(bar, b.x, nloc, nx); b.st[0] = nloc; b.st[1] = nx; }
        const unsigned old = xb_add(&bar[XB_XSUB(b.x)], 1u);
        const unsigned gen = old / nloc;
        if (old + 1u == (gen + 1u) * nloc) {
            __builtin_amdgcn_fence(__ATOMIC_RELEASE, "agent");
            asm volatile("s_waitcnt vmcnt(0)" ::: "memory");
            const unsigned og = xb_add(&bar[XB_TOP], 1u);
            const unsigned tg = og / nx;
            if (og + 1u == (tg + 1u) * nx) xb_add(&bar[XB_TOPGEN], 1u);
            else XB_SPIN(xb_ld(&bar[XB_TOPGEN]) == tg, bar);
            __builtin_amdgcn_fence(__ATOMIC_ACQUIRE, "agent");
            xb_add(&bar[XB_XGEN(b.x)], 1u);
            asm volatile("s_waitcnt vmcnt(0)" ::: "memory");
        } else {
            XB_SPIN(xb_ld(&bar[XB_XGEN(b.x)]) == gen, bar);
            __builtin_amdgcn_fence(__ATOMIC_ACQUIRE, "agent");
            asm volatile("s_waitcnt vmcnt(0)" ::: "memory");
        }
    }
    __syncthreads();
    if (pfw_) asm volatile("s_waitcnt vmcnt(0)" : "+v"(pf0_), "+v"(pf1_) :: "memory");
}

struct Args { const void* in[29]; float* out; unsigned char* ws; int ph_lo, ph_hi; };
typedef const Args __attribute__((address_space(4)))* ArgsP;
struct Frame {
    LAS unsigned char* lds;
    unsigned char* ws;
    unsigned* ctl;
    int tid, lane, wave, bid, G;
};

struct CvtRegs { f32x4 v[8]; };
__device__ __forceinline__ void cvt_load(CvtRegs& r, const float* W, int ldw, int n0, int Nvalid, int k0, int lane) {
    const int rs = lane >> 3, c4 = lane & 7; const bool ok = (n0 + 4 * c4) < Nvalid;
#pragma unroll
    for (int i = 0; i < 8; ++i) { const f32x4 t = *(const f32x4*)(W + (size_t)(k0 + 8 * i + rs) * ldw + (ok ? n0 + 4 * c4 : 0)); r.v[i] = ok ? t : (f32x4){0.f, 0.f, 0.f, 0.f}; }
}
__device__ __forceinline__ void cvt_store(const CvtRegs& r, bf16* dst, int ldt, LAS float* scr, int lane) {
    const int rs = lane >> 3, c4 = lane & 7;
#pragma unroll
    for (int i = 0; i < 8; ++i) { LAS float* p = scr + (8 * i + rs) * 33 + 4 * c4; p[0] = r.v[i].x; p[1] = r.v[i].y; p[2] = r.v[i].z; p[3] = r.v[i].w; }
    LDS_WAIT(); asm volatile("" ::: "memory");
    const int c = lane & 7;
#pragma unroll
    for (int j = 0; j < 4; ++j) { const int n = (lane >> 3) + 8 * j; const LAS float* s = scr + (8 * c) * 33 + n;
        u32x4 o; o.x = pk2(s[0 * 33], s[1 * 33]); o.y = pk2(s[2 * 33], s[3 * 33]); o.z = pk2(s[4 * 33], s[5 * 33]); o.w = pk2(s[6 * 33], s[7 * 33]);
        *(u32x4*)(dst + (size_t)n * ldt + 8 * c) = o; }
    LDS_WAIT(); asm volatile("" ::: "memory");
}
struct CvtItem { const float* W; bf16* dst; int ldw, n0, Nvalid, k0, ldt; };
__device__ __forceinline__ CvtItem small_item(unsigned char* ws, ArgsP A, int l, int r) {
    constexpr int I0 = 32 * 224, I1 = 32 * 192, I2 = 8 * 64, I3 = 12 * 64, I4 = 12 * 64;
    CvtItem it;
    if (r < I0) { const int kb = r / 224, nb = r % 224; it = CvtItem{(const float*)A->in[3] + (size_t)l * D * NIN, (bf16*)(ws + WS_W1T) + (size_t)(32 * nb) * D + 64 * kb, NIN, 32 * nb, NIN, 64 * kb, D}; return it; } r -= I0;
    if (r < I1) { const int kb = r / 192, nb = r % 192; it = CvtItem{(const float*)A->in[21] + (size_t)l * D * NGATE, (bf16*)(ws + WS_WGT) + (size_t)(32 * nb) * D + 64 * kb, NGATE, 32 * nb, NGATE, 64 * kb, D}; return it; } r -= I1;
    if (r < I2) { const int kb = r / 64, nb = r % 64; it = CvtItem{(const float*)A->in[18] + (size_t)l * WA * D, (bf16*)(ws + WS_WOUTT) + (size_t)(32 * nb) * D + 0 + 64 * kb, D, 32 * nb, D, 64 * kb, D}; return it; } r -= I2;
    if (r < I3) { const int kb = r / 64, nb = r % 64; it = CvtItem{(const float*)A->in[19] + (size_t)l * WB * D, (bf16*)(ws + WS_WOUTT) + (size_t)(32 * nb) * D + 512 + 64 * kb, D, 32 * nb, D, 64 * kb, D}; return it; } r -= I3;
    if (r < I4) { const int kb = r / 64, nb = r % 64; it = CvtItem{(const float*)A->in[20] + (size_t)l * WC * D, (bf16*)(ws + WS_WOUTT) + (size_t)(32 * nb) * D + 1280 + 64 * kb, D, 32 * nb, D, 64 * kb, D}; return it; } r -= I4;
    { const int kb = r / 64, nb = r % 64; it = CvtItem{(const float*)A->in[23] + (size_t)l * D * D, (bf16*)(ws + WS_WOT) + (size_t)(32 * nb) * D + 64 * kb, D, 32 * nb, D, 64 * kb, D}; return it; }
}
__device__ __forceinline__ void phase_convert(const Frame& F, ArgsP A, int l) {
    LAS float* scr = (LAS float*)(F.lds + F.wave * 8704);
    const int gw = F.bid * 8 + F.wave, NGW = F.G * 8;
    unsigned char* ws = F.ws;
    constexpr int NIT = 32 * 224 + 32 * 192 + 8 * 64 + 12 * 64 + 12 * 64 + 32 * 64;
    CvtRegs cur, nxt; CvtItem ci, ni;
    int it = gw;
    if (it < NIT) { ci = small_item(ws, A, l, it); cvt_load(cur, ci.W, ci.ldw, ci.n0, ci.Nvalid, ci.k0, F.lane); }
    for (; it < NIT; it += NGW) {
        const bool more = it + NGW < NIT;
        if (more) { ni = small_item(ws, A, l, it + NGW); cvt_load(nxt, ni.W, ni.ldw, ni.n0, ni.Nvalid, ni.k0, F.lane); }
        cvt_store(cur, ci.dst, ci.ldt, scr, F.lane);
        if (more) { cur = nxt; ci = ni; }
    }
    const float* w_r = (const float*)A->in[25] + (size_t)l * D * NE;
    float* wrt = (float*)(ws + WS_WRT);
    for (int i = F.bid * 512 + F.tid; i < D * NE; i += F.G * 512) { const int e = i >> 11, k = i & 2047; wrt[i] = w_r[k * NE + e]; }
}
constexpr int N_CVT_UNITS = 768;
__device__ __forceinline__ CvtItem expert_item(unsigned char* ws, ArgsP A, int l, int r) {
    CvtItem it;
    if (r < 32768) { const int up = r >= 16384; if (up) r -= 16384; const int e = r >> 10, kb = (r & 1023) >> 5, nb = r & 31, n0 = 32 * nb;
        const int row = (n0 >> 7) * 256 + (n0 & 127) + up * 128;
        it = CvtItem{(const float*)A->in[up ? 27 : 26] + ((size_t)l * NE + e) * D * FF, (bf16*)(ws + WS_WGU) + ((size_t)e * 2048 + row) * D + 64 * kb, FF, n0, FF, 64 * kb, D};
    } else { r -= 32768; const int e = r >> 10, kb = (r & 1023) >> 6, nb = r & 63;
        it = CvtItem{(const float*)A->in[28] + ((size_t)l * NE + e) * FF * D, (bf16*)(ws + WS_WDN) + ((size_t)e * 2048 + 32 * nb) * FF + 64 * kb, D, 32 * nb, D, 64 * kb, FF}; }
    return it;
}
__device__ __forceinline__ void convert_expert_unit(const Frame& F, ArgsP A, int l, int cu) {
    LAS float* scr = (LAS float*)(F.lds + F.wave * 8704);
    unsigned char* ws = F.ws;
    const int r0 = cu * 64 + F.wave * 8;
    CvtRegs cur, nxt; CvtItem ci = expert_item(ws, A, l, r0), ni;
    cvt_load(cur, ci.W, ci.ldw, ci.n0, ci.Nvalid, ci.k0, F.lane);
#pragma unroll 1
    for (int k = 0; k < 8; ++k) {
        if (k + 1 < 8) { ni = expert_item(ws, A, l, r0 + k + 1); cvt_load(nxt, ni.W, ni.ldw, ni.n0, ni.Nvalid, ni.k0, F.lane); }
        cvt_store(cur, ci.dst, ci.ldt, scr, F.lane);
        if (k + 1 < 8) { cur = nxt; ci = ni; }
    }
}
__device__ __forceinline__ void rms_row_to_bf16(const float* xrow, const float* gain, bf16* orow, int lane) {
    const f32x4* xr = (const f32x4*)xrow + lane; const f32x4* gr = (const f32x4*)gain + lane;
    f32x4 v[8]; float s = 0.f;
#pragma unroll
    for (int j = 0; j < 8; ++j) { v[j] = xr[64 * j]; s += (v[j].x * v[j].x + v[j].y * v[j].y) + (v[j].z * v[j].z + v[j].w * v[j].w); }
    const float rstd = 1.f / sqrtf(wave_sum(s) * (1.f / D) + EPS);
    u32x2* o = (u32x2*)orow + lane;
#pragma unroll
    for (int j = 0; j < 8; ++j) { const f32x4 g = gr[64 * j]; u32x2 w; w.x = pk2(v[j].x * rstd * g.x, v[j].y * rstd * g.y); w.y = pk2(v[j].z * rstd * g.z, v[j].w * rstd * g.w); o[64 * j] = w; }
}
__device__ __forceinline__ void phase_rms_x(const Frame& F, const float* x, const float* gain) {
    const int gw = F.bid * 8 + F.wave, NGW = F.G * 8;
    for (int m = gw; m < M; m += NGW) rms_row_to_bf16(x + (size_t)m * D, gain, (bf16*)(F.ws + WS_XN) + (size_t)m * D, F.lane);
}

__device__ __forceinline__ int krow(int s, int h, int j) { return 16 * s + 8 * (j >> 2) + 4 * h + (j & 3); }
__device__ __forceinline__ int crow(int reg, int h) { return (reg & 3) + 8 * (reg >> 2) + 4 * h; }
__device__ __forceinline__ float softplusf_(float x) { return x > 20.f ? x : log1pf(expf(x)); }

#define MFMA32(a, b, c) __builtin_amdgcn_mfma_f32_32x32x16_bf16((a), (b), (c), 0, 0, 0)
__device__ __forceinline__ bf16x8 pack8(const f32x16& x, int s) {
    u32x4 p; p.x = pk2(x[8 * s + 0], x[8 * s + 1]); p.y = pk2(x[8 * s + 2], x[8 * s + 3]); p.z = pk2(x[8 * s + 4], x[8 * s + 5]); p.w = pk2(x[8 * s + 6], x[8 * s + 7]);
    return __builtin_bit_cast(bf16x8, p);
}
typedef short v4i16_t __attribute__((ext_vector_type(4)));
constexpr int NP_K = 0, NP_Q = 16384, NP_V = 32768, NP_L = 49152, NP_T = 83968, NP_TAB = 139264, NP_CS = 141824, NP_END = 145920;
constexpr int LP = 68;
constexpr int TP = 144;
static_assert(NP_END <= MISC_OFF, "prep lds");
__device__ __forceinline__ int swzf(int row) { return ((row & 3) << 2) | ((row >> 2) & 3); }
__device__ __forceinline__ bf16x8 img_frag(const LAS unsigned char* img, int row, int s, int hh) {
    return *(const LAS bf16x8*)(img + row * 256 + (((2 * s + hh) ^ swzf(row)) << 4)); }
__device__ __forceinline__ s16x4 tr_read4(const LAS unsigned char* p) { return __builtin_bit_cast(s16x4, __builtin_amdgcn_ds_read_tr16_b64_v4i16((LAS v4i16_t*)p)); }
__device__ __forceinline__ bf16x8 img_frag_tr(const LAS unsigned char* img, int s, int cb, int lane, int flip) {
    const int hh = lane >> 5, i16 = lane & 15, q_ = i16 >> 2, p = i16 & 3, blk = (lane >> 4) & 1;
    const int c0 = 16 * s + 4 * hh + q_, r0 = flip ? 63 - c0 : c0, r1 = flip ? 55 - c0 : c0 + 8;
    const int chunk = 4 * cb + 2 * blk + (p >> 1), within = 8 * (p & 1);
    const s16x4 lo = tr_read4(img + r0 * 256 + ((chunk ^ swzf(r0)) << 4) + within), hi = tr_read4(img + r1 * 256 + ((chunk ^ swzf(r1)) << 4) + within);
    return (bf16x8){lo[0], lo[1], lo[2], lo[3], hi[0], hi[1], hi[2], hi[3]};
}

__device__ __forceinline__ void phase_prep(Frame& F, ArgsP A, int l) {
    int& tid = F.tid; int lane = F.lane, wave = F.wave;
    unsigned char* ws = F.ws;
    const bf16* PROJ = (const bf16*)(ws + WS_PROJ);
    bf16* MMIX = (bf16*)(ws + WS_MMIX);
    bf16* QKB = (bf16*)(ws + WS_QKB);
#define RELAUNDER() do { asm volatile("" : "+v"(tid)); lane = tid & 63; wave = __builtin_amdgcn_readfirstlane(tid >> 6); } while (0)
    const float* SCAL = (const float*)(ws + WS_SCAL);
    const float* conv_c = (const float*)A->in[12] + (size_t)l * 3 * 2304;
    LAS float* cs = (LAS float*)(F.lds + NP_CS);

    for (int unit = F.bid; unit < BATCH * NCHUNK; unit += F.G) {
        const int b = unit >> 6, chunk = unit & 63, t0 = chunk * 64, m0 = b * SEQ + t0;
        const bf16* P0 = PROJ + (size_t)m0 * NPROJ;
        RELAUNDER();
#ifndef NO_PREP_AB
#pragma unroll 1
        for (int rab_ = 0; rab_ < (DBLP == 1 ? 2 : 1); ++rab_) {
        {
            const float* conv_a = (const float*)A->in[4] + (size_t)l * 3 * WA;
#pragma unroll 1
            for (int k = 0; k < 4; ++k) {
                const int it = tid + 512 * k, rg = it >> 8, cp = it & 255, r0 = 8 * rg;
                const f32x2 w0 = *(const f32x2*)(conv_a + 0 * WA + 2 * cp), w1 = *(const f32x2*)(conv_a + 1 * WA + 2 * cp), w2 = *(const f32x2*)(conv_a + 2 * WA + 2 * cp);
                unsigned cr[10], vr[10], br[8];
#pragma unroll
                for (int i = 0; i < 10; ++i) { const int r = r0 - 1 + i, t = t0 + r; const bool ok = (t >= 0 && t < SEQ); const bf16* row = P0 + (ptrdiff_t)(ok ? r : r0) * NPROJ;
                    const unsigned c = *(const unsigned*)(row + PC_CA + 2 * cp), v = *(const unsigned*)(row + PC_VA + 2 * cp); cr[i] = ok ? c : 0u; vr[i] = ok ? v : 0u; }
#pragma unroll
                for (int i = 0; i < 8; ++i) br[i] = *(const unsigned*)(P0 + (size_t)(r0 + i) * NPROJ + PC_BA + 2 * cp);
                f32x2 cv[10];
#pragma unroll
                for (int i = 0; i < 10; ++i) cv[i] = (f32x2){bflo(cr[i]) * bflo(vr[i]), bfhi(cr[i]) * bfhi(vr[i])};
#pragma unroll
                for (int i = 0; i < 8; ++i) { const f32x2 y = w0 * cv[i] + w1 * cv[i + 1] + w2 * cv[i + 2];
                    *(unsigned*)(MMIX + (size_t)(m0 + r0 + i) * D + 2 * cp) = pk2(bflo(br[i]) * y.x, bfhi(br[i]) * y.y); }
            }
        }
        RELAUNDER();
        {
            const float* q_norm = (const float*)A->in[5] + l * 64; const float* k_norm = (const float*)A->in[6] + l * 64;
            { const int row = tid >> 3, j = tid & 7; const int pos = ((const int*)A->in[1])[m0 + row];
              const float inv = powf(500000.f, -(float)(2 * j) / 16.f); const float ang = (float)pos * inv;
              float sn, cn; sincosf(ang, &sn, &cn);
              cs[row * 16 + j] = cn; cs[row * 16 + 8 + j] = sn; }
            __syncthreads();
            const int e8 = lane & 7;
            float gq[8], gk[8];
#pragma unroll
            for (int i = 0; i < 8; ++i) { gq[i] = q_norm[8 * e8 + i]; gk[i] = k_norm[8 * e8 + i]; }
#pragma unroll 1
            for (int it0 = 0; it0 < 24; it0 += 12) {
                u32x4 raws[12];
#pragma unroll
                for (int j = 0; j < 12; ++j) { const int v = (it0 + j) * 64 + wave * 8 + (lane >> 3); const int row = v / 24, vv = v % 24; const int isk = vv >= 12, hc = vv % 12;
                    raws[j] = *(const u32x4*)(P0 + (size_t)row * NPROJ + (isk ? PC_KB : PC_QB) + hc * 64 + 8 * e8); }
#pragma unroll
                for (int j = 0; j < 12; ++j) {
                const int v = (it0 + j) * 64 + wave * 8 + (lane >> 3); const int row = v / 24, vv = v % 24; const int isk = vv >= 12, hc = vv % 12;
                const u32x4 raw = raws[j];
                float x[8]; x[0] = bflo(raw.x); x[1] = bfhi(raw.x); x[2] = bflo(raw.y); x[3] = bfhi(raw.y); x[4] = bflo(raw.z); x[5] = bfhi(raw.z); x[6] = bflo(raw.w); x[7] = bfhi(raw.w);
                float ss = 0.f;
#pragma unroll
                for (int i = 0; i < 8; ++i) ss += x[i] * x[i];
                ss += shx<1>(ss); ss += shx<2>(ss); ss += shx<4>(ss);
                const float rstd = 1.f / sqrtf(ss * (1.f / 64.f) + EPS);
                float y[8], oth[8];
#pragma unroll
                for (int i = 0; i < 8; ++i) y[i] = x[i] * rstd * (isk ? gk[i] : gq[i]);
#pragma unroll
                for (int i = 0; i < 8; ++i) oth[i] = shx<1>(y[i]);
                if (e8 < 2) {
#pragma unroll
                    for (int i = 0; i < 8; ++i) { const float c = cs[row * 16 + i], s = cs[row * 16 + 8 + i];
                        y[i] = (e8 == 0) ? (y[i] * c - oth[i] * s) : (y[i] * c + oth[i] * s); }
                }
                const float sc = isk ? 1.f : 0.125f * 1.4426950408889634f;
                u32x4 o; o.x = pk2(y[0] * sc, y[1] * sc); o.y = pk2(y[2] * sc, y[3] * sc); o.z = pk2(y[4] * sc, y[5] * sc); o.w = pk2(y[6] * sc, y[7] * sc);
                *(u32x4*)(QKB + (size_t)(m0 + row) * 1536 + (isk ? 768 : 0) + hc * 64 + 8 * e8) = o;
                }
            }
        }
        __syncthreads(); }
#endif
#ifndef NO_PREP_C
        unsigned raw[3][10];
        auto fetch_raw = [&](int hh_) {
#pragma unroll
            for (int mat = 0; mat < 3; ++mat) { const int col = (mat == 0 ? PC_QC : (mat == 1 ? PC_KC : PC_VC)) + hh_ * 128 + 2 * lane;
#pragma unroll
                for (int i = 0; i < 10; ++i) { const int r = 8 * wave - 1 + i, t = t0 + r; const bool ok = (t >= 0 && t < SEQ);
                    const unsigned w = *(const unsigned*)(P0 + (ptrdiff_t)(ok ? r : 8 * wave) * NPROJ + col); raw[mat][i] = ok ? w : 0u; } } };
        fetch_raw(0);
#pragma unroll 1
        for (int hx = 0; hx < (DBLP == 2 ? 2 * HC : HC); ++hx) { const int h = hx % HC;
            LBAR();
            RELAUNDER();
            LAS unsigned char* kimg = F.lds + NP_K; LAS unsigned char* qimg = F.lds + NP_Q; LAS unsigned char* vimg = F.lds + NP_V;
            {
#pragma unroll
                for (int mat = 0; mat < 3; ++mat) {
                    const int wch = mat * 768 + h * 128 + 2 * lane;
                    const f32x2 cw0 = *(const f32x2*)(conv_c + 0 * 2304 + wch), cw1 = *(const f32x2*)(conv_c + 1 * 2304 + wch), cw2 = *(const f32x2*)(conv_c + 2 * 2304 + wch);
                    LAS unsigned char* img = F.lds + (mat == 0 ? NP_Q : (mat == 1 ? NP_K : NP_V));
                    f32x2 xr[10];
#pragma unroll
                    for (int i = 0; i < 10; ++i) xr[i] = (f32x2){bflo(raw[mat][i]), bfhi(raw[mat][i])};
#pragma unroll
                    for (int i = 0; i < 8; ++i) { const int row = 8 * wave + i;
                        f32x2 a = cw0 * xr[i] + cw1 * xr[i + 1] + cw2 * xr[i + 2]; a.x = siluf_(a.x); a.y = siluf_(a.y);
                        if (mat < 2) { const float ss = wave_sum(a.x * a.x + a.y * a.y); const float sc = (1.f / sqrtf(ss + EPS)) * (mat == 0 ? 0.08838834764831845f : 1.f); a.x *= sc; a.y *= sc; }
                        *(LAS unsigned*)(img + row * 256 + (((lane >> 2) ^ swzf(row)) << 4) + (lane & 3) * 4) = pk2(a.x, a.y); }
                }
            }
            if (hx + 1 < (DBLP == 2 ? 2 * HC : HC)) fetch_raw((hx + 1) % HC);
            if (wave < 2) {
                const int d = wave, i = lane, row = d ? 63 - i : i; const float* sc = SCAL + (size_t)(m0 + row) * 32;
                const float beta = sigmoidf_(sc[d * 6 + h]);
                const float a = sc[12 + d * 6 + h];
                const float al = ((const float*)A->in[d ? 14 : 13])[l * 6 + h], db = ((const float*)A->in[d ? 16 : 15])[l * 6 + h];
                float g = -expf(al) * softplusf_(a + db) * 1.4426950408889634f;
#pragma unroll
                for (int o = 1; o < 64; o <<= 1) { const float t = shfl_up_f(g, o, lane); if (lane >= o) g += t; }
                const float glast = __builtin_bit_cast(float, __builtin_amdgcn_readlane(__builtin_bit_cast(int, g), 63));
                LAS float* tab = (LAS float*)(F.lds + NP_TAB) + d * 320;
                const float e2 = __builtin_amdgcn_exp2f(g);
                tab[i] = beta; tab[64 + i] = g; tab[128 + i] = e2; tab[192 + i] = beta * e2; tab[256 + i] = __builtin_amdgcn_exp2f(glast - g);
            }
            LBAR();
            RELAUNDER();
            const int d = wave >> 2, wj = wave & 3, r32 = lane & 31, hh = lane >> 5;
            const LAS float* tab = (const LAS float*)(F.lds + NP_TAB) + d * 320;
            LAS float* Ld = (LAS float*)(F.lds + NP_L) + d * (64 * LP);
            LAS unsigned char* Tp = F.lds + NP_T + d * 27648; LAS unsigned char* Tb = Tp + 9216; LAS unsigned char* Tbg = Tp + 18432;
            const int chain = (b * HC + h) * 2 + d, step = d ? 63 - chunk : chunk;
            const size_t inst = (size_t)chain * 64 + step;
            unsigned char* op = ws + WS_SCANOP + inst * SCANOP_BYTES;
#define FR(i) (d ? 63 - (i) : (i))
            {
                const int kk_mb = (wj == 0) ? 0 : 1, kk_nb = (wj == 1) ? 1 : 0, x_jb = (wj == 1) ? 1 : 0, x_ib = (wj == 0) ? 0 : 1;
                if (wj != 3) {
                    f32x16 acc;
#pragma unroll
                    for (int r = 0; r < 16; ++r) acc[r] = 0.f;
#pragma unroll
                    for (int s = 0; s < 8; ++s) acc = MFMA32(img_frag(kimg, FR(32 * kk_mb + r32), s, hh), img_frag(kimg, FR(32 * kk_nb + r32), s, hh), acc);
                    const int jc = 32 * kk_nb + r32; const float gj = tab[64 + jc];
#pragma unroll
                    for (int r = 0; r < 16; ++r) { const int i = 32 * kk_mb + crow(r, hh);
                        Ld[i * LP + jc] = (jc < i) ? acc[r] * tab[i] * __builtin_amdgcn_exp2f(tab[64 + i] - gj) : 0.f; }
                }
                if (wj != 2) {
                    f32x16 acc;
#pragma unroll
                    for (int r = 0; r < 16; ++r) acc[r] = 0.f;
#pragma unroll
                    for (int s = 0; s < 8; ++s) acc = MFMA32(img_frag(kimg, FR(32 * x_jb + r32), s, hh), img_frag(qimg, FR(32 * x_ib + r32), s, hh), acc);
                    const int i = 32 * x_ib + r32; const float gi = tab[64 + i];
#pragma unroll
                    for (int r = 0; r < 16; ++r) { const int jj = 32 * x_jb + crow(r, hh); acc[r] = (jj <= i) ? acc[r] * __builtin_amdgcn_exp2f(gi - tab[64 + jj]) : 0.f; }
#pragma unroll
                    for (int hf = 0; hf < 2; ++hf) *(bf16x8*)(op + SO_A + ((x_ib * 4 + 2 * x_jb + hf) * 64 + lane) * 16) = pack8(acc, hf);
                }
            }
            LBAR();
            RELAUNDER();
            if (wj == 0) {
                const int i0 = 32 * hh, c = r32; float sol[32];
                f32x4 cur[8], nxt[8];
#pragma unroll
                for (int j4 = 0; j4 < 8; ++j4) { cur[j4] = (f32x4){0.f, 0.f, 0.f, 0.f}; nxt[j4] = cur[j4]; }
                sol[0] = (c == 0) ? 1.f : 0.f;
                cur[0] = *(const LAS f32x4*)(Ld + (i0 + 1) * LP + i0);
#pragma unroll
                for (int i = 1; i < 32; ++i) {
                    if (i + 1 < 32) {
#pragma unroll
                        for (int j4 = 0; j4 < (i + 4) / 4; ++j4) nxt[j4] = *(const LAS f32x4*)(Ld + (i0 + i + 1) * LP + i0 + 4 * j4);
                    }
                    float a0 = (i == c) ? 1.f : 0.f, a1 = 0.f, a2 = 0.f, a3 = 0.f;
#pragma unroll
                    for (int j4 = 0; j4 < (i + 3) / 4; ++j4) { const f32x4 lv = cur[j4];
                        if (4 * j4 + 0 < i) a0 -= lv.x * sol[4 * j4 + 0]; if (4 * j4 + 1 < i) a1 -= lv.y * sol[4 * j4 + 1];
                        if (4 * j4 + 2 < i) a2 -= lv.z * sol[4 * j4 + 2]; if (4 * j4 + 3 < i) a3 -= lv.w * sol[4 * j4 + 3]; }
                    float a = (a0 + a1) + (a2 + a3);
                    asm volatile("" : "+v"(a) :: "memory"); sol[i] = a;
#pragma unroll
                    for (int j4 = 0; j4 < 8; ++j4) cur[j4] = nxt[j4];
                }
                const float bc = tab[i0 + c], bgc = tab[192 + i0 + c];
#pragma unroll
                for (int i = 0; i < 32; ++i) { const int off = (i0 + i) * TP + (i0 + c) * 2;
                    *(LAS bf16*)(Tp + off) = (bf16)f2bf(sol[i]); *(LAS bf16*)(Tb + off) = (bf16)f2bf(sol[i] * bc); *(LAS bf16*)(Tbg + off) = (bf16)f2bf(sol[i] * bgc);
                    if (hh == 1) { const int zo = i * TP + (32 + c) * 2; *(LAS bf16*)(Tb + zo) = 0; *(LAS bf16*)(Tbg + zo) = 0; } }
            } else {
#pragma unroll 1
                for (int f = wj - 1; f < 32; f += 3) {
                    if (f < 16) {
                        const int mb = f >> 3, s = f & 7, i = 32 * mb + r32, row = FR(i); const float eg = tab[128 + i];
                        const LAS unsigned char* rp = qimg + row * 256 + 8 * hh;
                        const u32x2 lo = *(const LAS u32x2*)(rp + (((2 * s) ^ swzf(row)) << 4)), hi = *(const LAS u32x2*)(rp + (((2 * s + 1) ^ swzf(row)) << 4));
                        u32x4 o; o.x = pk2(bflo(lo.x) * eg, bfhi(lo.x) * eg); o.y = pk2(bflo(lo.y) * eg, bfhi(lo.y) * eg); o.z = pk2(bflo(hi.x) * eg, bfhi(hi.x) * eg); o.w = pk2(bflo(hi.y) * eg, bfhi(hi.y) * eg);
                        *(u32x4*)(op + SO_Q + (f * 64 + lane) * 16) = o;
                    } else {
                        const int g = f - 16, a = g >> 2, s = g & 3;
                        const bf16x8 kf = img_frag_tr(kimg, s, a, lane, d);
                        const f32x4 d0 = *(const LAS f32x4*)(tab + 256 + 16 * s + 4 * hh), d1 = *(const LAS f32x4*)(tab + 256 + 16 * s + 8 + 4 * hh);
                        u32x4 o; o.x = pk2(bf2f((bf16)kf[0]) * d0.x, bf2f((bf16)kf[1]) * d0.y); o.y = pk2(bf2f((bf16)kf[2]) * d0.z, bf2f((bf16)kf[3]) * d0.w);
                        o.z = pk2(bf2f((bf16)kf[4]) * d1.x, bf2f((bf16)kf[5]) * d1.y); o.w = pk2(bf2f((bf16)kf[6]) * d1.z, bf2f((bf16)kf[7]) * d1.w);
                        *(u32x4*)(op + SO_K + (g * 64 + lane) * 16) = o;
                    }
                }
                if (wj == 1 && lane == 0) ((float*)(ws + WS_EW + 256 * 1024))[inst] = tab[128 + 63];
            }
            LBAR();
            RELAUNDER();
            if (wj == 0) {
                f32x16 P;
#pragma unroll
                for (int r = 0; r < 16; ++r) P[r] = 0.f;
#pragma unroll
                for (int s = 0; s < 2; ++s) {
                    const LAS float* lp = Ld + (32 + r32) * LP + 16 * s + 4 * hh; const f32x4 l0 = *(const LAS f32x4*)lp, l1 = *(const LAS f32x4*)(lp + 8);
                    u32x4 aw; aw.x = pk2(l0.x, l0.y); aw.y = pk2(l0.z, l0.w); aw.z = pk2(l1.x, l1.y); aw.w = pk2(l1.z, l1.w);
                    const int i16 = lane & 15, q_ = i16 >> 2, p = i16 & 3, blk = (lane >> 4) & 1;
                    const LAS unsigned char* tp = Tp + (16 * s + 4 * hh + q_) * TP + blk * 32 + p * 8;
                    const s16x4 lo = tr_read4(tp), hi = tr_read4(tp + 8 * TP);
                    P = MFMA32(__builtin_bit_cast(bf16x8, aw), ((bf16x8){lo[0], lo[1], lo[2], lo[3], hi[0], hi[1], hi[2], hi[3]}), P);
                }
                f32x16 T21;
#pragma unroll
                for (int r = 0; r < 16; ++r) T21[r] = 0.f;
#pragma unroll
                for (int s = 0; s < 2; ++s) {
                    const LAS unsigned char* tp = Tp + (32 + r32) * TP + (32 + 16 * s + 4 * hh) * 2;
                    const u32x2 lo = *(const LAS u32x2*)tp, hi = *(const LAS u32x2*)(tp + 16);
                    u32x4 aw; aw.x = lo.x; aw.y = lo.y; aw.z = hi.x; aw.w = hi.y;
                    T21 = MFMA32(__builtin_bit_cast(bf16x8, aw), pack8(P, s), T21);
                }
                const float bc = tab[r32], bgc = tab[192 + r32];
#pragma unroll
                for (int r = 0; r < 16; ++r) { const int off = (32 + crow(r, hh)) * TP + r32 * 2; const float v = -T21[r];
                    *(LAS bf16*)(Tb + off) = (bf16)f2bf(v * bc); *(LAS bf16*)(Tbg + off) = (bf16)f2bf(v * bgc); }
            }
            LBAR();
            RELAUNDER();
            {
                f32x16 au[2], aw[2];
#pragma unroll
                for (int mb = 0; mb < 2; ++mb)
#pragma unroll
                    for (int r = 0; r < 16; ++r) { au[mb][r] = 0.f; aw[mb][r] = 0.f; }
#pragma unroll
                for (int s = 0; s < 4; ++s) {
                    const bf16x8 vf = img_frag_tr(vimg, s, wj, lane, d), kf = img_frag_tr(kimg, s, wj, lane, d);
#pragma unroll
                    for (int mb = 0; mb < 2; ++mb) {
                        if (mb == 0 && s >= 2) continue;
                        const int to = (32 * mb + r32) * TP + (16 * s + 4 * hh) * 2;
                        const u32x2 b0 = *(const LAS u32x2*)(Tb + to), b1 = *(const LAS u32x2*)(Tb + to + 16), g0 = *(const LAS u32x2*)(Tbg + to), g1 = *(const LAS u32x2*)(Tbg + to + 16);
                        u32x4 tbw, tgw; tbw.x = b0.x; tbw.y = b0.y; tbw.z = b1.x; tbw.w = b1.y; tgw.x = g0.x; tgw.y = g0.y; tgw.z = g1.x; tgw.w = g1.y;
                        au[mb] = MFMA32(__builtin_bit_cast(bf16x8, tbw), vf, au[mb]);
                        aw[mb] = MFMA32(kf, __builtin_bit_cast(bf16x8, tgw), aw[mb]);
                    }
                }
#pragma unroll
                for (int mb = 0; mb < 2; ++mb) {
                    u32x4 o0, o1; o0.x = pk2(au[mb][0], au[mb][1]); o0.y = pk2(au[mb][2], au[mb][3]); o0.z = pk2(au[mb][4], au[mb][5]); o0.w = pk2(au[mb][6], au[mb][7]);
                    o1.x = pk2(au[mb][8], au[mb][9]); o1.y = pk2(au[mb][10], au[mb][11]); o1.z = pk2(au[mb][12], au[mb][13]); o1.w = pk2(au[mb][14], au[mb][15]);
                    u32x4* up = (u32x4*)(op + SO_U + ((wj * 2 + mb) * 64 + lane) * 32); up[0] = o0; up[1] = o1;
#pragma unroll
                    for (int r = 0; r < 16; ++r) aw[mb][r] = -aw[mb][r];
#pragma unroll
                    for (int hf = 0; hf < 2; ++hf) *(bf16x8*)(op + SO_W + ((mb * 8 + 2 * wj + hf) * 64 + lane) * 16) = pack8(aw[mb], hf);
                }
            }
#undef FR
        }
#endif
        __syncthreads();
    }
#undef RELAUNDER
}

constexpr int SC_GE = 2 * SCANOP_BYTES;
static_assert(SC_GE + 64 <= MISC_OFF, "scan lds");
__device__ __forceinline__ void scan_chain_wg(const Frame& F, int chain) {
    unsigned char* ws = F.ws; const int lane = F.lane, wave = F.wave;
    const int b = chain / 12, h = (chain >> 1) % 6, d = chain & 1;
    const unsigned char* op0 = ws + WS_SCANOP + (size_t)chain * 64 * SCANOP_BYTES;
    const float* GE = (const float*)(ws + WS_EW + 256 * 1024) + chain * 64;
    float* O = (float*)(ws + (d ? WS_OB : WS_OF));
    const int r32 = lane & 31, hh = lane >> 5;
    LAS unsigned char* lds = F.lds;
    const bool loader = wave >= 4;
    auto fill = [&](int step, int buf) {
        const unsigned char* src = op0 + (size_t)step * SCANOP_BYTES + (wave - 4) * 1024 + lane * 16;
        asm volatile("" : "+v"(src));
#pragma unroll
        for (int k = 0; k < 18; ++k) { const int pi = (wave - 4) + 4 * k;
            __builtin_amdgcn_global_load_lds((const unsigned*)(src + k * 4096), (LAS unsigned*)(lds + buf * SCANOP_BYTES + pi * 1024), 16, 0, 0); }
        if (wave == 4 && lane == 0) *(LAS float*)(lds + SC_GE + 4 * buf) = GE[step];
    };
    f32x16 S[4];
#pragma unroll
    for (int a = 0; a < 4; ++a)
#pragma unroll
        for (int r = 0; r < 16; ++r) S[a][r] = 0.f;
    if (loader) fill(0, 0);
    asm volatile("s_waitcnt vmcnt(0) lgkmcnt(0)" ::: "memory"); __builtin_amdgcn_s_barrier(); asm volatile("" ::: "memory");
    for (int step = 0; step < 64; ++step) {
        const int buf = step & 1;
        if (loader) {
            if (step + 1 < 64) fill(step + 1, buf ^ 1);
            asm volatile("s_waitcnt vmcnt(0) lgkmcnt(0)" ::: "memory");
        } else {
            const int slice = wave;
            const int chunk = d ? 63 - step : step;
            const LAS unsigned char* op = lds + buf * SCANOP_BYTES + lane * 16;
            const float ge = *(const LAS float*)(lds + SC_GE + 4 * buf);
            bf16x8 Sb[8];
#pragma unroll
            for (int a = 0; a < 4; ++a) { Sb[2 * a] = pack8(S[a], 0); Sb[2 * a + 1] = pack8(S[a], 1); }
            f32x16 vn[2];
#pragma unroll
            for (int mb = 0; mb < 2; ++mb) {
                const LAS u32x4* up = (const LAS u32x4*)(lds + buf * SCANOP_BYTES + SO_U + ((slice * 2 + mb) * 64 + lane) * 32);
                const u32x4 u0 = up[0], u1 = up[1];
                vn[mb][0] = bflo(u0.x); vn[mb][1] = bfhi(u0.x); vn[mb][2] = bflo(u0.y); vn[mb][3] = bfhi(u0.y); vn[mb][4] = bflo(u0.z); vn[mb][5] = bfhi(u0.z); vn[mb][6] = bflo(u0.w); vn[mb][7] = bfhi(u0.w);
                vn[mb][8] = bflo(u1.x); vn[mb][9] = bfhi(u1.x); vn[mb][10] = bflo(u1.y); vn[mb][11] = bfhi(u1.y); vn[mb][12] = bflo(u1.z); vn[mb][13] = bfhi(u1.z); vn[mb][14] = bflo(u1.w); vn[mb][15] = bfhi(u1.w);
            }
#pragma unroll
            for (int s = 0; s < 8; ++s)
#pragma unroll
                for (int mb = 0; mb < 2; ++mb) vn[mb] = MFMA32(*(const LAS bf16x8*)(op + SO_W + (mb * 8 + s) * 1024), Sb[s], vn[mb]);
            asm volatile("" ::: "memory"); __builtin_amdgcn_sched_barrier(0);
            bf16x8 Vb[4];
#pragma unroll
            for (int mb = 0; mb < 2; ++mb) { Vb[2 * mb] = pack8(vn[mb], 0); Vb[2 * mb + 1] = pack8(vn[mb], 1); }
#pragma unroll
            for (int a = 0; a < 4; ++a) {
#pragma unroll
                for (int r = 0; r < 16; ++r) S[a][r] *= ge;
            }
#pragma unroll
            for (int s = 0; s < 4; ++s)
#pragma unroll
                for (int a = 0; a < 4; ++a) S[a] = MFMA32(*(const LAS bf16x8*)(op + SO_K + (a * 4 + s) * 1024), Vb[s], S[a]);
            asm volatile("" ::: "memory"); __builtin_amdgcn_sched_barrier(0);
            f32x16 o[2];
#pragma unroll
            for (int mb = 0; mb < 2; ++mb)
#pragma unroll
                for (int r = 0; r < 16; ++r) o[mb][r] = 0.f;
#pragma unroll
            for (int s = 0; s < 8; ++s)
#pragma unroll
                for (int mb = 0; mb < 2; ++mb) o[mb] = MFMA32(*(const LAS bf16x8*)(op + SO_Q + (mb * 8 + s) * 1024), Sb[s], o[mb]);
            asm volatile("" ::: "memory"); __builtin_amdgcn_sched_barrier(0);
#pragma unroll
            for (int mb = 0; mb < 2; ++mb)
#pragma unroll
                for (int s = 0; s < 2 * (mb + 1); ++s) o[mb] = MFMA32(*(const LAS bf16x8*)(op + SO_A + (mb * 4 + s) * 1024), Vb[s], o[mb]);
            float* Ou = O + (size_t)(b * SEQ + chunk * 64) * WC + h * 128 + 32 * slice;
            const int voff = (d ? 4 - 4 * hh : 4 * hh) * WC + r32;
#pragma unroll
            for (int mb = 0; mb < 2; ++mb)
#pragma unroll
                for (int r = 0; r < 16; ++r) { const int ri = 32 * mb + (r & 3) + 8 * (r >> 2); float* rowp = Ou + (d ? 59 - ri : ri) * WC; rowp[voff] = o[mb][r]; }
            asm volatile("s_waitcnt lgkmcnt(0)" ::: "memory");
        }
        asm volatile("" ::: "memory"); __builtin_amdgcn_s_barrier(); asm volatile("" ::: "memory");
    }
}

__device__ __forceinline__ void glds16(const void* gsrc, unsigned lds_dst) { unsigned keep;
    asm volatile("s_mov_b32 %0, m0\n\ts_mov_b32 m0, %2\n\ts_nop 0\n\tglobal_load_lds_dwordx4 %1, off\n\ts_mov_b32 m0, %0" : "=&s"(keep) : "v"(gsrc), "s"(lds_dst) : "memory"); }
constexpr int AL_K = 0, AL_V = 18432, AL_BUF = 34816, AL_OST = 0, AL_LST = 65536, AL_LTAB = 66048;
static_assert(3 * AL_BUF <= MISC_OFF && AL_LTAB + 512 <= 3 * AL_BUF, "attn lds");
__device__ __forceinline__ void attn_unit(const Frame& F, int b, int h, int qb, float lam, float negM2, const float* subln, float out_scale) {
    const int lane = F.lane, wave = F.wave, qg = wave & 3, c = wave >> 2, r32 = lane & 31, hh = lane >> 5;
    unsigned char* ws = F.ws;
    const bf16* QKB = (const bf16*)(ws + WS_QKB);
    const bf16* PROJ = (const bf16*)(ws + WS_PROJ);
    bf16* MMIX = (bf16*)(ws + WS_MMIX);
    const size_t rowb = (size_t)b * SEQ;
    bf16x8 qf[4];
    { const bf16* Qrow = QKB + (rowb + qb * 128 + qg * 32 + r32) * 1536 + h * 128 + c * 64;
#pragma unroll
      for (int s = 0; s < 4; ++s) qf[s] = *(const bf16x8*)(Qrow + 16 * s + 8 * hh);
      asm volatile("" :: "v"(qf[0]), "v"(qf[1]), "v"(qf[2]), "v"(qf[3])); }
    f32x16 O[4];
#pragma unroll
    for (int db = 0; db < 4; ++db)
#pragma unroll
        for (int r = 0; r < 16; ++r) O[db][r] = 0.f;
    float lsum = 0.f;
    unsigned doff[5];
#pragma unroll
    for (int k = 0; k < 5; ++k) { int pi = wave + 8 * k; if (pi >= 34) pi -= 8;
        const int p = pi * 64 + lane; unsigned o = 0u;
        if (pi < 18) { const int cc = p / 576, q = p % 576, row = q / 9; int ch = q % 9; ch = ch > 7 ? 7 : ch; o = (unsigned)((row * 1536 + cc * 64 + 8 * ch) * 2); }
        else { const int pp = p - 1152, db = pp >> 8, row = (pp >> 2) & 63, c4 = pp & 3; o = (unsigned)((row * NPROJ + 32 * db + 8 * c4) * 2); }
        doff[k] = o; }
    const char* kbase = (const char*)(QKB + rowb * 1536 + 768 + h * 128);
    const char* vbase = (const char*)(PROJ + rowb * NPROJ + PC_VB + h * 128);
    const unsigned lds0 = (unsigned)(uintptr_t)F.lds;
    auto dma = [&](int T, int buf) {
        const char* kb = kbase + (size_t)T * (64 * 1536 * 2); const char* vb = vbase + (size_t)T * (64 * NPROJ * 2);
#pragma unroll
        for (int k = 0; k < 5; ++k) { int pi = wave + 8 * k; if (pi >= 34) pi -= 8;
            glds16((pi < 18 ? kb : vb) + doff[k], (unsigned)__builtin_amdgcn_readfirstlane((int)(lds0 + buf * AL_BUF + pi * 1024))); } };
    dma(0, 0); dma(1, 1);
    const int vlane = ((lane >> 4) & 1) * 32 + (lane & 3) * 8 + (4 * hh + ((lane & 15) >> 2)) * 64;
    int bcur = 0, bnxt2 = 2;
    if (c == 1) __builtin_amdgcn_s_setprio(1);
    for (int T = 0; T < 64; ++T) {
        if (T + 1 < 64) asm volatile("s_waitcnt vmcnt(5)" ::: "memory"); else asm volatile("s_waitcnt vmcnt(0)" ::: "memory");
        asm volatile("s_waitcnt lgkmcnt(0)" ::: "memory"); __builtin_amdgcn_s_barrier(); asm volatile("" ::: "memory");
        if (T + 2 < 64) dma(T + 2, bnxt2);
        const LAS unsigned char* lbuf = F.lds + bcur * AL_BUF;
        bcur = (bcur == 2) ? 0 : bcur + 1; bnxt2 = (bnxt2 == 2) ? 0 : bnxt2 + 1;
        const unsigned ka = (unsigned)(uintptr_t)(lbuf + AL_K + c * 9216) + (unsigned)(r32 * 144 + 16 * hh);
        const unsigned va = (unsigned)(uintptr_t)(lbuf + AL_V) + (unsigned)vlane;
#define KRD(dst, off) asm volatile("ds_read_b128 %0, %1 offset:%c2" : "=&v"(dst) : "v"(ka), "i"(off) : "memory")
#define VRD(dst, off) asm volatile("ds_read_b64_tr_b16 %0, %1 offset:%c2" : "=&v"(dst) : "v"(va), "i"(off) : "memory")
#define VGRP(L, H, db_) do { VRD(L[0], (db_) * 4096); VRD(H[0], (db_) * 4096 + 512); VRD(L[1], (db_) * 4096 + 1024); VRD(H[1], (db_) * 4096 + 1536); \
            VRD(L[2], (db_) * 4096 + 2048); VRD(H[2], (db_) * 4096 + 2560); VRD(L[3], (db_) * 4096 + 3072); VRD(H[3], (db_) * 4096 + 3584); } while (0)
#define VWAIT(N, L, H) asm volatile("s_waitcnt lgkmcnt(" #N ")" : "+v"(L[0]), "+v"(H[0]), "+v"(L[1]), "+v"(H[1]), "+v"(L[2]), "+v"(H[2]), "+v"(L[3]), "+v"(H[3]) :: "memory")
#define VFR(L, H, s_) ((bf16x8){L[s_][0], L[s_][1], L[s_][2], L[s_][3], H[s_][0], H[s_][1], H[s_][2], H[s_][3]})
        bf16x8 kf[8];
        KRD(kf[0], 0); KRD(kf[1], 32); KRD(kf[2], 64); KRD(kf[3], 96); KRD(kf[4], 4608); KRD(kf[5], 4640); KRD(kf[6], 4672); KRD(kf[7], 4704);
        asm volatile("s_waitcnt lgkmcnt(4)" : "+v"(kf[0]), "+v"(kf[1]), "+v"(kf[2]), "+v"(kf[3]) :: "memory");
        f32x16 s0, s1;
#pragma unroll
        for (int r = 0; r < 16; ++r) { s0[r] = negM2; s1[r] = negM2; }
#pragma unroll
        for (int s = 0; s < 4; ++s) s0 = MFMA32(kf[s], qf[s], s0);
        asm volatile("s_waitcnt lgkmcnt(0)" : "+v"(kf[4]), "+v"(kf[5]), "+v"(kf[6]), "+v"(kf[7]) :: "memory");
#pragma unroll
        for (int s = 0; s < 4; ++s) s1 = MFMA32(kf[4 + s], qf[s], s1);
        s16x4 vl0[4], vh0[4], vl1[4], vh1[4];
        VGRP(vl0, vh0, 0);
        bf16x8 pf[4];
        { float ls = 0.f;
#pragma unroll
          for (int r = 0; r < 16; ++r) { s0[r] = __builtin_amdgcn_exp2f(s0[r]); ls += s0[r]; }
          pf[0] = pack8(s0, 0); pf[1] = pack8(s0, 1);
#pragma unroll
          for (int r = 0; r < 16; ++r) { s1[r] = __builtin_amdgcn_exp2f(s1[r]); ls += s1[r]; }
          pf[2] = pack8(s1, 0); pf[3] = pack8(s1, 1);
          lsum += ls; }
        VGRP(vl1, vh1, 1);
        VWAIT(8, vl0, vh0);
#pragma unroll
        for (int s = 0; s < 4; ++s) O[0] = MFMA32(pf[s], VFR(vl0, vh0, s), O[0]);
        s16x4 vl2[4], vh2[4];
        VGRP(vl2, vh2, 2);
        VWAIT(8, vl1, vh1);
#pragma unroll
        for (int s = 0; s < 4; ++s) O[1] = MFMA32(pf[s], VFR(vl1, vh1, s), O[1]);
        s16x4 vl3[4], vh3[4];
        VGRP(vl3, vh3, 3);
        VWAIT(8, vl2, vh2);
#pragma unroll
        for (int s = 0; s < 4; ++s) O[2] = MFMA32(pf[s], VFR(vl2, vh2, s), O[2]);
        VWAIT(0, vl3, vh3);
#pragma unroll
        for (int s = 0; s < 4; ++s) O[3] = MFMA32(pf[s], VFR(vl3, vh3, s), O[3]);
#undef KRD
#undef VRD
#undef VGRP
#undef VWAIT
#undef VFR
    }
    __builtin_amdgcn_s_setprio(0);
    lsum += shx<32>(lsum);
    LAS float* Ost = (LAS float*)(F.lds + AL_OST); LAS float* Lst = (LAS float*)(F.lds + AL_LST); LAS float* Ltab = (LAS float*)(F.lds + AL_LTAB);
    __syncthreads();
    if (c == 1) {
        if (hh == 0) Lst[qg * 32 + r32] = lsum;
#pragma unroll
        for (int db = 0; db < 4; ++db)
#pragma unroll
            for (int r = 0; r < 16; ++r) Ost[((qg * 4 + db) * 16 + r) * 64 + lane] = O[db][r];
    } else if (hh == 0) Ltab[qg * 32 + r32] = lsum;
    __syncthreads();
    if (c == 0) {
#pragma unroll
        for (int r = 0; r < 16; ++r) {
            const int q = crow(r, hh);
            const float i0 = 1.f / Ltab[qg * 32 + q], i1 = lam / Lst[qg * 32 + q];
            float ss = 0.f;
#pragma unroll
            for (int db = 0; db < 4; ++db) { const float v = O[db][r] * i0 - Ost[((qg * 4 + db) * 16 + r) * 64 + lane] * i1; O[db][r] = v; ss += v * v; }
            ss += shx<1>(ss); ss += shx<2>(ss); ss += shx<4>(ss); ss += shx<8>(ss); ss += shx<16>(ss);
            const float rstd = out_scale / sqrtf(ss * (1.f / 128.f) + EPS);
            bf16* orow = MMIX + (rowb + qb * 128 + qg * 32 + q) * D + WA + h * 128 + r32;
#pragma unroll
            for (int db = 0; db < 4; ++db) orow[32 * db] = (bf16)f2bf(O[db][r] * rstd * subln[32 * db + r32]);
        }
    }
    __syncthreads();
}

__device__ __forceinline__ void phase_delta_fin(const Frame& F, const float* o_norm) {
    const int gw = F.bid * 8 + F.wave, NGW = F.G * 8, lane = F.lane;
    const float* OF = (const float*)(F.ws + WS_OF); const float* OB = (const float*)(F.ws + WS_OB);
    const bf16* PROJ = (const bf16*)(F.ws + WS_PROJ); bf16* MMIX = (bf16*)(F.ws + WS_MMIX);
    const f32x2 gn = *(const f32x2*)(o_norm + 2 * lane);
    for (int m = 2 * gw; m < M; m += 2 * NGW) {
        f32x2 a[2][HC], c[2][HC]; unsigned g[2][HC];
#pragma unroll
        for (int r = 0; r < 2; ++r)
#pragma unroll
            for (int h = 0; h < HC; ++h) { a[r][h] = *(const f32x2*)(OF + (size_t)(m + r) * WC + h * 128 + 2 * lane); c[r][h] = *(const f32x2*)(OB + (size_t)(m + r) * WC + h * 128 + 2 * lane);
                g[r][h] = *(const unsigned*)(PROJ + (size_t)(m + r) * NPROJ + PC_GC + h * 128 + 2 * lane); }
#pragma unroll
        for (int r = 0; r < 2; ++r)
#pragma unroll
            for (int h = 0; h < HC; ++h) {
                const float o0 = a[r][h].x + c[r][h].x, o1 = a[r][h].y + c[r][h].y;
                const float rstd = 1.f / sqrtf(wave_sum(o0 * o0 + o1 * o1) * (1.f / 128.f) + EPS);
                *(unsigned*)(MMIX + (size_t)(m + r) * D + WA + WB + h * 128 + 2 * lane) = pk2(o0 * rstd * gn.x * siluf_(bflo(g[r][h])), o1 * rstd * gn.y * siluf_(bfhi(g[r][h])));
            }
    }
}

__device__ __forceinline__ void tile_of(int L, int nM, int nN, int& pm, int& pn) {
    const int nwg = nM * nN; int wgid = L; { const int q = nwg / 8, r = nwg % 8, xcd = wgid % 8, off = wgid / 8; wgid = (xcd < r ? xcd * (q + 1) : r * (q + 1) + (xcd - r) * q) + off; }
    const int nig = 8 * nN, gid = wgid / nig, fm = gid * 8, gsz = (nM - fm) < 8 ? (nM - fm) : 8;
    pm = fm + ((wgid % nig) % gsz); pn = (wgid % nig) / gsz;
}
struct SchedPlain {
    const char* A; const char* Bt; int lda, ldb, nM, nN, nt, G, c;
    __device__ __forceinline__ bool next(int i, pg8::Unit& u) const {
        const long L = (long)i * G + c; if (L >= (long)nM * nN) return false;
        int pm, pn; tile_of((int)L, nM, nN, pm, pn);
        u.a = A + (size_t)pm * 256 * lda * 2; u.b = Bt + (size_t)pn * 256 * ldb * 2; u.nt = nt; u.pm = pm; u.pn = pn; u.aux = 0; return true; }
    __device__ __forceinline__ int row_index(const pg8::Unit&, int) const { return 0; }
};
struct SchedOutProj {
    const char* A; const char* Bt; int G, c;
    __device__ __forceinline__ bool next(int i, pg8::Unit& u) const {
        const int ti = i / 3, br = i - 3 * ti; const long L = (long)ti * G + c; if (L >= 512) return false;
        int pm, pn; tile_of((int)L, 64, 8, pm, pn);
        const int koff = br == 0 ? 0 : (br == 1 ? 512 : 1280);
        u.a = A + ((size_t)pm * 256 * D + koff) * 2; u.b = Bt + ((size_t)pn * 256 * D + koff) * 2; u.nt = br == 0 ? 8 : 12; u.pm = pm; u.pn = pn; u.aux = br; return true; }
    __device__ __forceinline__ int row_index(const pg8::Unit&, int) const { return 0; }
};
struct SchedExpert {
    const char* A; const char* Bt; int lda, ldb, nt, G, c;
    __device__ __forceinline__ bool next(int i, pg8::Unit& u) const {
        const long L = (long)i * G + c; if (L >= 1024) return false;
        int e, pm, pn;
        if (G == 256) { const int i4 = (int)L >> 8, x = (int)L & 7, j = ((int)L >> 3) & 31; e = 4 * i4 + (x >> 1); pm = j & 7; pn = 4 * (x & 1) + (j >> 3); }
        else { e = (int)L >> 6; const int rem = (int)L & 63; pm = rem & 7; pn = rem >> 3; }
        const int row0 = ((pm >> 1) * 16 + e) * 512 + (pm & 1) * 256;
        u.a = A + (size_t)row0 * lda * 2; u.b = Bt + ((size_t)e * 2048 + pn * 256) * ldb * 2; u.nt = nt; u.pm = row0; u.pn = pn; u.aux = e; return true; }
    __device__ __forceinline__ int row_index(const pg8::Unit&, int) const { return 0; }
};
struct SchedExpertGather {
    const char* A; const char* Bt; const int* idx; int ldb, nt, G, c;
    __device__ __forceinline__ bool next(int i, pg8::Unit& u) const {
        const long L = (long)i * G + c; if (L >= 1024) return false;
        int e, pm, pn;
        if (G == 256) { const int i4 = (int)L >> 8, x = (int)L & 7, j = ((int)L >> 3) & 31; e = 4 * i4 + (x >> 1); pm = j & 7; pn = 4 * (x & 1) + (j >> 3); }
        else { e = (int)L >> 6; const int rem = (int)L & 63; pm = rem & 7; pn = rem >> 3; }
        const int row0 = ((pm >> 1) * 16 + e) * 512 + (pm & 1) * 256;
        u.a = A; u.b = Bt + ((size_t)e * 2048 + pn * 256) * ldb * 2; u.nt = nt; u.pm = row0; u.pn = pn; u.aux = e; return true; }
    __device__ __forceinline__ int row_index(const pg8::Unit& u, int r) const { return (u.pm >> 13) * SEQ + idx[u.pm + r]; }
};
typedef f32x4 acc_t[2][2][4][2];
struct EpiProj {
    static constexpr bool PERM = true; static constexpr bool KEEPS = false;
    bf16* proj; float* scal; unsigned char* gates; const float* bias;
    __device__ __forceinline__ void operator()(const acc_t& acc, const pg8::Unit& u, int wr, int wc, int fr, int fq) const {
        const int row0 = u.pm * 256 + wr * 64 + fr;
        if (u.pn < 27) {
            const int col0 = u.pn * 256 + wc * 32 + 8 * fq;
#pragma unroll
            for (int ai = 0; ai < 2; ++ai)
#pragma unroll
                for (int m = 0; m < 4; ++m) { bf16* rowp = proj + (size_t)(row0 + ai * 128 + m * 16) * NPROJ + col0;
#pragma unroll
                    for (int bj = 0; bj < 2; ++bj) { const f32x4 v0 = acc[ai][bj][m][0], v1 = acc[ai][bj][m][1];
                        u32x4 w; w.x = pk2(v0[0], v0[1]); w.y = pk2(v0[2], v0[3]); w.z = pk2(v1[0], v1[1]); w.w = pk2(v1[2], v1[3]);
                        *(u32x4*)(rowp + bj * 128) = w; } }
        } else if (u.pn == 27) {
            if (wc == 0) {
            const int col0 = 8 * fq;
#pragma unroll
            for (int ai = 0; ai < 2; ++ai)
#pragma unroll
                for (int m = 0; m < 4; ++m) { float* rowp = scal + (size_t)(row0 + ai * 128 + m * 16) * 32 + col0;
                    *(f32x4*)rowp = acc[ai][0][m][0]; *(f32x4*)(rowp + 4) = acc[ai][0][m][1]; }
            }
        } else {
            const int col0 = (u.pn - 28) * 256 + wc * 32 + 8 * fq;
            f32x4 bv[2][2];
#pragma unroll
            for (int bj = 0; bj < 2; ++bj)
#pragma unroll
                for (int n = 0; n < 2; ++n) bv[bj][n] = *(const f32x4*)(bias + col0 + bj * 128 + 4 * n);
#pragma unroll
            for (int ai = 0; ai < 2; ++ai)
#pragma unroll
                for (int m = 0; m < 4; ++m) { unsigned char* rowp = gates + (size_t)(row0 + ai * 128 + m * 16) * NGATE + col0;
#pragma unroll
                    for (int bj = 0; bj < 2; ++bj) { const f32x4 v0 = acc[ai][bj][m][0] + bv[bj][0], v1 = acc[ai][bj][m][1] + bv[bj][1];
#define Q8F(x) __builtin_amdgcn_rcpf((1.f / 255.f) + __builtin_amdgcn_exp2f(__builtin_fmaf((x), -1.4426950408889634f, -7.994353436858858f)))
                        u32x2 w; w.x = 0u; w.y = 0u;
                        w.x = __builtin_amdgcn_cvt_pk_u8_f32(Q8F(v0[0]), 0u, w.x); w.x = __builtin_amdgcn_cvt_pk_u8_f32(Q8F(v0[1]), 1u, w.x); w.x = __builtin_amdgcn_cvt_pk_u8_f32(Q8F(v0[2]), 2u, w.x); w.x = __builtin_amdgcn_cvt_pk_u8_f32(Q8F(v0[3]), 3u, w.x);
                        w.y = __builtin_amdgcn_cvt_pk_u8_f32(Q8F(v1[0]), 0u, w.y); w.y = __builtin_amdgcn_cvt_pk_u8_f32(Q8F(v1[1]), 1u, w.y); w.y = __builtin_amdgcn_cvt_pk_u8_f32(Q8F(v1[2]), 2u, w.y); w.y = __builtin_amdgcn_cvt_pk_u8_f32(Q8F(v1[3]), 3u, w.y);
#undef Q8F
                        *(u32x2*)(rowp + bj * 128) = w; } }
        }
    }
};
struct EpiGate {
    static constexpr bool PERM = true; static constexpr bool KEEPS = false;
    bf16* gates; const float* bias;
    __device__ __forceinline__ void operator()(const acc_t& acc, const pg8::Unit& u, int wr, int wc, int fr, int fq) const {
        const int row0 = u.pm * 256 + wr * 64 + fr, col0 = u.pn * 256 + wc * 32 + 8 * fq;
        f32x4 bv[2][2];
#pragma unroll
        for (int bj = 0; bj < 2; ++bj)
#pragma unroll
            for (int n = 0; n < 2; ++n) bv[bj][n] = *(const f32x4*)(bias + col0 + bj * 128 + 4 * n);
#pragma unroll
        for (int ai = 0; ai < 2; ++ai)
#pragma unroll
            for (int m = 0; m < 4; ++m) { bf16* rowp = gates + (size_t)(row0 + ai * 128 + m * 16) * NGATE + col0;
#pragma unroll
                for (int bj = 0; bj < 2; ++bj) { const f32x4 v0 = acc[ai][bj][m][0] + bv[bj][0], v1 = acc[ai][bj][m][1] + bv[bj][1];
                    u32x4 w; w.x = pk2(sigmoidf_(v0[0]), sigmoidf_(v0[1])); w.y = pk2(sigmoidf_(v0[2]), sigmoidf_(v0[3])); w.z = pk2(sigmoidf_(v1[0]), sigmoidf_(v1[1])); w.w = pk2(sigmoidf_(v1[2]), sigmoidf_(v1[3]));
                    *(u32x4*)(rowp + bj * 128) = w; } }
    }
};
struct EpiOutProj {
    static constexpr bool PERM = true; static constexpr bool KEEPS = true;
    const unsigned char* gates; bf16* z;
    __device__ __forceinline__ void operator()(acc_t& acc, const pg8::Unit& u, int wr, int wc, int fr, int fq) const {
        const int br = u.aux, trow0 = wr * 64 + fr, tcol0 = wc * 32 + 8 * fq;
#pragma unroll
        for (int ai = 0; ai < 2; ++ai)
#pragma unroll
        for (int mh = 0; mh < 2; ++mh) {
            u32x2 g[2][2], gn[2][2];
#pragma unroll
            for (int mm = 0; mm < 2; ++mm) { const int m = 2 * mh + mm; const int tr = trow0 + ai * 128 + m * 16; const size_t grow = (size_t)(u.pm * 256 + tr);
#pragma unroll
                for (int bj = 0; bj < 2; ++bj) { const int tc = tcol0 + bj * 128;
                    const unsigned char* gp = gates + grow * NGATE + br * D + u.pn * 256 + tc;
                    g[mm][bj] = *(const u32x2*)gp;
                    gn[mm][bj] = (br < 2) ? *(const u32x2*)(gp + D) : g[mm][bj]; } }
#pragma unroll
            for (int mm = 0; mm < 2; ++mm) { const int m = 2 * mh + mm; const int tr = trow0 + ai * 128 + m * 16; const size_t grow = (size_t)(u.pm * 256 + tr);
#pragma unroll
                for (int bj = 0; bj < 2; ++bj) { const int tc = tcol0 + bj * 128; const u32x2 gg = g[mm][bj], gd = gn[mm][bj];
                    f32x4 v0 = acc[ai][bj][m][0], v1 = acc[ai][bj][m][1];
                    float f[8];
#pragma unroll
                    for (int e = 0; e < 8; ++e) { const unsigned w = e < 4 ? gg.x : gg.y, wd = e < 4 ? gd.x : gd.y; const int sh = 8 * (e & 3);
                        const float num = fmaxf((float)((w >> sh) & 255u), 1.f);
                        f[e] = (br < 2) ? num * __builtin_amdgcn_rcpf(fmaxf((float)((wd >> sh) & 255u), 1.f)) : num * (1.f / 255.f); }
                    v0[0] *= f[0]; v0[1] *= f[1]; v0[2] *= f[2]; v0[3] *= f[3]; v1[0] *= f[4]; v1[1] *= f[5]; v1[2] *= f[6]; v1[3] *= f[7];
                    if (br < 2) { acc[ai][bj][m][0] = v0; acc[ai][bj][m][1] = v1; }
                    else { u32x4 w; w.x = pk2(v0[0], v0[1]); w.y = pk2(v0[2], v0[3]); w.z = pk2(v1[0], v1[1]); w.w = pk2(v1[2], v1[3]);
                        *(u32x4*)(z + grow * D + u.pn * 256 + tc) = w; } } }
            asm volatile("" ::: "memory");
        }
    }
};
struct EpiResid {
    static constexpr bool PERM = false; static constexpr bool KEEPS = false;
    const float* x; float* hout;
    __device__ __forceinline__ void operator()(const acc_t& acc, const pg8::Unit& u, int wr, int wc, int fr, int fq) const {
        const int row0 = u.pm * 256 + wr * 64 + fr, col0 = u.pn * 256 + wc * 32 + 4 * fq;
#pragma unroll
        for (int ai = 0; ai < 2; ++ai)
#pragma unroll
            for (int m = 0; m < 4; ++m) { const size_t off = (size_t)(row0 + ai * 128 + m * 16) * D + col0;
#pragma unroll
                for (int bj = 0; bj < 2; ++bj)
#pragma unroll
                    for (int n = 0; n < 2; ++n) { const f32x4 xv = *(const f32x4*)(x + off + bj * 128 + n * 16); *(f32x4*)(hout + off + bj * 128 + n * 16) = xv + acc[ai][bj][m][n]; } }
    }
};
struct EpiSwiglu {
    static constexpr bool PERM = true; static constexpr bool KEEPS = false;
    bf16* hid;
    __device__ __forceinline__ void operator()(const acc_t& acc, const pg8::Unit& u, int wr, int wc, int fr, int fq) const {
        const int row0 = u.pm + wr * 64 + fr, col0 = u.pn * 128 + wc * 32 + 8 * fq;
#pragma unroll
        for (int ai = 0; ai < 2; ++ai)
#pragma unroll
            for (int m = 0; m < 4; ++m) { const f32x4 g0 = acc[ai][0][m][0], g1 = acc[ai][0][m][1], u0 = acc[ai][1][m][0], u1 = acc[ai][1][m][1];
                u32x4 w; w.x = pk2(siluf_(g0[0]) * u0[0], siluf_(g0[1]) * u0[1]); w.y = pk2(siluf_(g0[2]) * u0[2], siluf_(g0[3]) * u0[3]);
                w.z = pk2(siluf_(g1[0]) * u1[0], siluf_(g1[1]) * u1[1]); w.w = pk2(siluf_(g1[2]) * u1[2], siluf_(g1[3]) * u1[3]);
                *(u32x4*)(hid + (size_t)(row0 + ai * 128 + m * 16) * FF + col0) = w; }
    }
};
struct EpiDown {
    static constexpr bool PERM = true; static constexpr bool KEEPS = false;
    bf16* y; const float* ew;
    __device__ __forceinline__ void operator()(const acc_t& acc, const pg8::Unit& u, int wr, int wc, int fr, int fq) const {
        const int row0 = u.pm + wr * 64 + fr, col0 = u.pn * 256 + wc * 32 + 8 * fq;
#pragma unroll
        for (int ai = 0; ai < 2; ++ai)
#pragma unroll
            for (int m = 0; m < 4; ++m) { const int row = row0 + ai * 128 + m * 16; const float wgt = ew[row]; bf16* rowp = y + (size_t)row * D + col0;
#pragma unroll
                for (int bj = 0; bj < 2; ++bj) { const f32x4 v0 = acc[ai][bj][m][0] * wgt, v1 = acc[ai][bj][m][1] * wgt;
                    u32x4 w; w.x = pk2(v0[0], v0[1]); w.y = pk2(v0[2], v0[3]); w.z = pk2(v1[0], v1[1]); w.w = pk2(v1[2], v1[3]);
                    *(u32x4*)(rowp + bj * 128) = w; } }
    }
};

__device__ __forceinline__ float reduce16(float (&p)[16], int lane) {
#define RS_STEP(M, N) { const bool up = (lane & (M)) != 0; _Pragma("unroll") for (int i = 0; i < (N) / 2; ++i) { const float keep = up ? p[(N) / 2 + i] : p[i], send = up ? p[i] : p[(N) / 2 + i]; p[i] = keep + shx<(M)>(send); } }
    RS_STEP(32, 16) RS_STEP(16, 8) RS_STEP(8, 4) RS_STEP(4, 2)
#undef RS_STEP
    float r = p[0]; r += shx<1>(r); r += shx<2>(r); return r;
}
__device__ __forceinline__ void phase_router(const Frame& F, const float* hbuf, const float* gain) {
    LAS float* wT = (LAS float*)F.lds;
    const float* wrt = (const float*)(F.ws + WS_WRT);
    for (int i = F.tid; i < NE * D / 4; i += 512) *(LAS f32x4*)(wT + 4 * i) = *(const f32x4*)(wrt + 4 * i);
    __syncthreads();
    const int gw = F.bid * 8 + F.wave, NGW = F.G * 8, lane = F.lane;
    float* AFF = (float*)(F.ws + WS_AFF); bf16* XN = (bf16*)(F.ws + WS_XN);
    const int myexp = ((lane >> 5) & 1) * 8 + ((lane >> 4) & 1) * 4 + ((lane >> 3) & 1) * 2 + ((lane >> 2) & 1);
    for (int m = 2 * gw; m < M; m += 2 * NGW) {
        const f32x4* gr = (const f32x4*)gain + lane;
        f32x4 v[2][8]; float s[2] = {0.f, 0.f};
#pragma unroll
        for (int r = 0; r < 2; ++r) { const f32x4* xr = (const f32x4*)(hbuf + (size_t)(m + r) * D) + lane;
#pragma unroll
            for (int j = 0; j < 8; ++j) { v[r][j] = xr[64 * j]; s[r] += (v[r][j].x * v[r][j].x + v[r][j].y * v[r][j].y) + (v[r][j].z * v[r][j].z + v[r][j].w * v[r][j].w); } }
        const float rstd0 = 1.f / sqrtf(wave_sum(s[0]) * (1.f / D) + EPS), rstd1 = 1.f / sqrtf(wave_sum(s[1]) * (1.f / D) + EPS);
#pragma unroll
        for (int j = 0; j < 8; ++j) { const f32x4 g = gr[64 * j]; v[0][j] = v[0][j] * rstd0 * g; v[1][j] = v[1][j] * rstd1 * g; }
#pragma unroll
        for (int r = 0; r < 2; ++r) { u32x2* o = (u32x2*)(XN + (size_t)(m + r) * D) + lane;
#pragma unroll
            for (int j = 0; j < 8; ++j) { u32x2 w; w.x = pk2(v[r][j].x, v[r][j].y); w.y = pk2(v[r][j].z, v[r][j].w); o[64 * j] = w; } }
        float p0[16], p1[16];
#pragma unroll
        for (int e = 0; e < NE; ++e) { float a0 = 0.f, a1 = 0.f;
#pragma unroll
            for (int j = 0; j < 8; ++j) { const f32x4 w = *(LAS f32x4*)(wT + e * D + 4 * (lane + 64 * j));
                a0 = __builtin_fmaf(v[0][j].x, w.x, a0); a1 = __builtin_fmaf(v[1][j].x, w.x, a1); a0 = __builtin_fmaf(v[0][j].y, w.y, a0); a1 = __builtin_fmaf(v[1][j].y, w.y, a1);
                a0 = __builtin_fmaf(v[0][j].z, w.z, a0); a1 = __builtin_fmaf(v[1][j].z, w.z, a1); a0 = __builtin_fmaf(v[0][j].w, w.w, a0); a1 = __builtin_fmaf(v[1][j].w, w.w, a1); }
            asm volatile("" : "+v"(a0), "+v"(a1) :: "memory"); p0[e] = a0; p1[e] = a1; }
        float lg[2] = {reduce16(p0, lane), reduce16(p1, lane)};
#pragma unroll
        for (int r = 0; r < 2; ++r) {
            float mx = lg[r]; mx = fmaxf(mx, shx<4>(mx)); mx = fmaxf(mx, shx<8>(mx)); mx = fmaxf(mx, shx<16>(mx)); mx = fmaxf(mx, shx<32>(mx));
            const float ex = expf(lg[r] - mx); float den = ex; den += shx<4>(den); den += shx<8>(den); den += shx<16>(den); den += shx<32>(den);
            if ((lane & 3) == 0) AFF[(size_t)(m + r) * NE + myexp] = ex / den;
        }
    }
    __syncthreads();
}

__device__ __forceinline__ int block_excl_scan(int v, LAS int* tmp, int tid, int lane, int wave, int& total) {
    int inc = v;
#pragma unroll
    for (int o = 1; o < 64; o <<= 1) { const int t = shfl_up_i(inc, o, lane); if (lane >= o) inc += t; }
    __syncthreads();
    if (lane == 63) tmp[wave] = inc;
    __syncthreads();
    int base = 0, tot = 0;
#pragma unroll
    for (int w = 0; w < 8; ++w) { const int t = tmp[w]; if (w < wave) base += t; tot += t; }
    total = tot;
    return base + inc - v;
}
__device__ __forceinline__ void phase_topk(const Frame& F) {
    LAS int* hist = (LAS int*)F.lds;
    LAS int* tmp = (LAS int*)(F.lds + 1024);
    LAS int* bc = (LAS int*)(F.lds + 1088);
    const float* AFF = (const float*)(F.ws + WS_AFF);
    int* SEL = (int*)(F.ws + WS_SEL); int* IDX = (int*)(F.ws + WS_IDX); float* EW = (float*)(F.ws + WS_EW);
    const int tid = F.tid, lane = F.lane, wave = F.wave;
    for (int u = F.bid; u < BATCH * NE; u += F.G) {
        const int b = u >> 4, e = u & 15;
        unsigned key[8];
#pragma unroll
        for (int i = 0; i < 8; ++i) key[i] = __builtin_bit_cast(unsigned, AFF[(size_t)(b * SEQ + 8 * tid + i) * NE + e]);
        unsigned prefix = 0u, mask = 0u; int need = CAP;
        for (int pass = 3; pass >= 0; --pass) {
            __syncthreads();
            if (tid < 256) hist[tid] = 0;
            __syncthreads();
#pragma unroll
            for (int i = 0; i < 8; ++i) if ((key[i] & mask) == prefix) (void)__hip_atomic_fetch_add(&hist[(key[i] >> (8 * pass)) & 255u], 1, __ATOMIC_RELAXED, __HIP_MEMORY_SCOPE_WORKGROUP);
            __syncthreads();
            {
                const int hv = (tid < 256) ? hist[255 - tid] : 0;
                int tot_; const int above = block_excl_scan(hv, tmp, tid, lane, wave, tot_);
                if (tid < 256 && above < need && above + hv >= need) { bc[0] = 255 - tid; bc[1] = need - above; }
            }
            __syncthreads();
            prefix |= (unsigned)bc[0] << (8 * pass); mask |= 0xffu << (8 * pass); need = bc[1];
        }
        const unsigned thr = prefix;
        int neq = 0;
#pragma unroll
        for (int i = 0; i < 8; ++i) neq += (key[i] == thr);
        int tot; int eqr = block_excl_scan(neq, tmp, tid, lane, wave, tot);
        int sel[8], nsel = 0;
#pragma unroll
        for (int i = 0; i < 8; ++i) { const bool eq = key[i] == thr; sel[i] = (key[i] > thr) || (eq && eqr < need); eqr += eq; nsel += sel[i]; }
        int slot = block_excl_scan(nsel, tmp, tid, lane, wave, tot);
#pragma unroll
        for (int i = 0; i < 8; ++i) { const int t = 8 * tid + i;
            if (sel[i]) { IDX[u * CAP + slot] = t; EW[u * CAP + slot] = __builtin_bit_cast(float, key[i]); SEL[(size_t)(b * SEQ + t) * NE + e] = slot; ++slot; }
            else SEL[(size_t)(b * SEQ + t) * NE + e] = -1; }
    }
    __syncthreads();
}
__device__ __forceinline__ void phase_gather(const Frame& F) {
    const int gw = F.bid * 8 + F.wave, NGW = F.G * 8, lane = F.lane;
    const int* IDX = (const int*)(F.ws + WS_IDX); const bf16* XN = (const bf16*)(F.ws + WS_XN); bf16* XS = (bf16*)(F.ws + WS_XS);
    for (int r = gw; r < BATCH * NE * CAP; r += NGW) {
        const int b = r >> 13, t = IDX[r];
        const u32x4* src = (const u32x4*)(XN + (size_t)(b * SEQ + t) * D) + lane; u32x4* dst = (u32x4*)(XS + (size_t)r * D) + lane;
#pragma unroll
        for (int j = 0; j < 4; ++j) dst[64 * j] = src[64 * j];
    }
}
__device__ __forceinline__ void phase_combine(const Frame& F, float* hbuf, const float* next_gain) {
    const int gw = F.bid * 8 + F.wave, NGW = F.G * 8, lane = F.lane;
    const int* SEL = (const int*)(F.ws + WS_SEL); const bf16* Y = (const bf16*)(F.ws + WS_YSLOT);
    for (int m = 2 * gw; m < M; m += 2 * NGW) {
        f32x4 v[2][8]; int mysel[2];
#pragma unroll
        for (int r = 0; r < 2; ++r) { const f32x4* xr = (const f32x4*)(hbuf + (size_t)(m + r) * D) + lane;
#pragma unroll
            for (int j = 0; j < 8; ++j) v[r][j] = xr[64 * j];
            mysel[r] = (lane < NE) ? SEL[(size_t)(m + r) * NE + lane] : -1; }
        const int b = m >> 12;
        unsigned mk0 = (unsigned)(__ballot(mysel[0] >= 0) & 0xffffull), mk1 = (unsigned)(__ballot(mysel[1] >= 0) & 0xffffull);
        while (mk0 | mk1) {
            int ee[2][2]; u32x2 yy[2][2][8];
#pragma unroll
            for (int r = 0; r < 2; ++r) { unsigned mk = r ? mk1 : mk0;
#pragma unroll
                for (int k = 0; k < 2; ++k) { ee[r][k] = mk ? __builtin_ctz(mk) : -1; mk &= mk - 1; }
                if (r) mk1 = mk; else mk0 = mk; }
#pragma unroll
            for (int r = 0; r < 2; ++r)
#pragma unroll
                for (int k = 0; k < 2; ++k)
                    if (ee[r][k] >= 0) { const int sl = __builtin_amdgcn_readlane(mysel[r], ee[r][k]); const u32x2* yr = (const u32x2*)(Y + (size_t)((b * NE + ee[r][k]) * CAP + sl) * D) + lane;
#pragma unroll
                        for (int j = 0; j < 8; ++j) yy[r][k][j] = yr[64 * j]; }
#pragma unroll
            for (int r = 0; r < 2; ++r)
#pragma unroll
                for (int k = 0; k < 2; ++k)
                    if (ee[r][k] >= 0) {
#pragma unroll
                        for (int j = 0; j < 8; ++j) { v[r][j].x += bflo(yy[r][k][j].x); v[r][j].y += bfhi(yy[r][k][j].x); v[r][j].z += bflo(yy[r][k][j].y); v[r][j].w += bfhi(yy[r][k][j].y); } }
        }
#pragma unroll
        for (int r = 0; r < 2; ++r) { f32x4* xr = (f32x4*)(hbuf + (size_t)(m + r) * D) + lane;
#pragma unroll
            for (int j = 0; j < 8; ++j) xr[64 * j] = v[r][j]; }
        if (next_gain) {
            const f32x4* gr = (const f32x4*)next_gain + lane;
#pragma unroll
            for (int r = 0; r < 2; ++r) {
                float s = 0.f;
#pragma unroll
                for (int j = 0; j < 8; ++j) s += (v[r][j].x * v[r][j].x + v[r][j].y * v[r][j].y) + (v[r][j].z * v[r][j].z + v[r][j].w * v[r][j].w);
                const float rstd = 1.f / sqrtf(wave_sum(s) * (1.f / D) + EPS);
                u32x2* o = (u32x2*)((bf16*)(F.ws + WS_XN) + (size_t)(m + r) * D) + lane;
#pragma unroll
                for (int j = 0; j < 8; ++j) { const f32x4 g = gr[64 * j]; u32x2 w; w.x = pk2(v[r][j].x * rstd * g.x, v[r][j].y * rstd * g.y); w.y = pk2(v[r][j].z * rstd * g.z, v[r][j].w * rstd * g.w); o[64 * j] = w; }
            }
        }
    }
}

constexpr int NPH = 14;
template <int PSEL>
__device__ __forceinline__ void layer_body(Frame& F, const ArgsP kp, const int l) {
#define SEAM(k) do { if (PSEL < 0) { ArgsP A_ = kp; asm volatile("" : "+s"(A_)); LAS unsigned char* l_ = F.lds; asm volatile("" : "+s"(l_)); int w_ = F.wave; asm volatile("" : "+s"(w_)); int t_; asm volatile("v_mbcnt_lo_u32_b32 %0, -1, 0\n\tv_mbcnt_hi_u32_b32 %0, -1, %0" : "=v"(t_)); t_ += w_ * 64; \
        XcdBarrier b_; b_.bar = (unsigned*)(A_->ws + WS_CTL) + CW_BAR; b_.x = xb_xcc_id(); b_.st = (volatile LAS unsigned*)(l_ + MISC_OFF) + 8; xcd_barrier(b_, t_); } } while (0)
#ifndef PH_MASK
#define PH_MASK 0x3fff
#endif
#define IN(p) (((PH_MASK >> (p)) & 1) && (PSEL < 0 || PSEL == (p)))
#define PHASE_BEGIN() ArgsP A = kp; asm volatile("" : "+s"(A)); unsigned char* ws = A->ws; F.ws = ws; F.ctl = (unsigned*)(ws + WS_CTL); \
        { LAS unsigned char* l_ = F.lds; asm volatile("" : "+s"(l_)); F.lds = l_; } \
        { int w_ = F.wave; asm volatile("" : "+s"(w_)); int ln_; asm volatile("v_mbcnt_lo_u32_b32 %0, -1, 0\n\tv_mbcnt_hi_u32_b32 %0, -1, %0" : "=v"(ln_)); F.wave = w_; F.lane = ln_; F.tid = w_ * 64 + ln_; } \
        { int b_ = F.bid, g_ = F.G; asm volatile("" : "+s"(b_), "+s"(g_)); F.bid = b_; F.G = g_; }
        if (l == 0) {
        if (IN(0)) { PHASE_BEGIN(); phase_convert(F, A, l); phase_rms_x(F, (const float*)A->in[0], (const float*)A->in[2]); __syncthreads(); }
        SEAM(0);
        if (DBL == 0) { { PHASE_BEGIN(); phase_convert(F, A, l); phase_rms_x(F, (const float*)A->in[0], (const float*)A->in[2]); __syncthreads(); } SEAM(0); }
        }
        for (int rep_ = 0; rep_ < (DBL == 1 ? 2 : 1); ++rep_) {
        if (rep_) SEAM(1);
        if (IN(1)) { PHASE_BEGIN();
            SchedPlain S{(const char*)(ws + WS_XN), (const char*)(ws + WS_W1T), D, D, 64, 52, 32, F.G, F.bid};
            EpiProj E{(bf16*)(ws + WS_PROJ), (float*)(ws + WS_SCAL), (unsigned char*)(ws + WS_GATES), (const float*)A->in[22] + (size_t)l * NGATE};
            pg8::gemm_phase(F.lds, F.tid, D, D, S, E);
        }
        }
        SEAM(1);
        if (IN(2)) { PHASE_BEGIN(); phase_prep(F, A, l); }
        SEAM(2);
        if (DBL == 2) { { PHASE_BEGIN(); phase_prep(F, A, l); } SEAM(2); }
        for (int rep3 = 0; rep3 < (DBL == 33 ? 2 : 1); ++rep3) {
        if (rep3) SEAM(3);
        if (IN(3)) {
            { PHASE_BEGIN();
#ifndef NO_SCAN
            if (F.bid < 48 && (rep3 == 0 || (DBL3MASK & 1))) scan_chain_wg(F, F.bid);
#endif
            __syncthreads(); }
            if (DBL == 31) { PHASE_BEGIN(); if (F.bid < 48) scan_chain_wg(F, F.bid); __syncthreads(); }
            if (DBL >= 30) SEAM(3);
            { PHASE_BEGIN();
              if (F.bid >= 192 && (rep3 == 0 || (DBL3MASK & 2))) for (;;) {
                volatile LAS unsigned* MQ = (volatile LAS unsigned*)(F.lds + MISC_OFF);
                if (F.tid == 0) MQ[0] = __hip_atomic_fetch_add(F.ctl + CW_Q + 64 * (4 + l + 8 * rep3), 1u, RLX_AGENT);
                __syncthreads();
                const int u = (int)MQ[0];
                __syncthreads();
                if (u >= N_CVT_UNITS) break;
                convert_expert_unit(F, A, l, u);
              } }
            for (int rep = 0; rep < (DBL == 32 ? 2 : 1); ++rep) {
            PHASE_BEGIN();
            const float* qn = (const float*)A->in[5] + l * 64; const float* kn = (const float*)A->in[6] + l * 64;
            const float* lq1 = (const float*)A->in[7] + l * 64; const float* lk1 = (const float*)A->in[8] + l * 64;
            const float* lq2 = (const float*)A->in[9] + l * 64; const float* lk2 = (const float*)A->in[10] + l * 64;
            float d1 = 0.f, d2 = 0.f, gq = 0.f, gk = 0.f;
            for (int i = 0; i < 64; ++i) { d1 += lq1[i] * lk1[i]; d2 += lq2[i] * lk2[i]; gq = fmaxf(gq, fabsf(qn[i])); gk = fmaxf(gk, fabsf(kn[i])); }
            const float lam_init = 0.8f - 0.6f * expf(-0.3f * (float)l);
            const float lam = expf(d1) - expf(d2) + lam_init;
            const float negM2 = -(8.f * gq * gk * 1.4426950408889634f);
            const float* subln = (const float*)A->in[11] + l * 128;
            if (rep3 == 0 || (DBL3MASK & 4)) {
              const int xq = (int)(xb_xcc_id() & 7u);
#pragma unroll 1
              for (int kq = 0; kq < 8; ++kq) {
                const int q = (xq + kq) & 7;
                for (;;) {
                    volatile LAS unsigned* MQ = (volatile LAS unsigned*)(F.lds + MISC_OFF);
                    if (F.tid == 0) MQ[0] = __hip_atomic_fetch_add(F.ctl + CW_Q + 64 * (32 + ((l * 2 + rep) * 2 + rep3) * 8 + q), 1u, RLX_AGENT);
                    __syncthreads();
                    const int u = (int)MQ[0];
                    __syncthreads();
                    if (u >= 3 * 32) break;
                    const int bh = q + 8 * (u >> 5), qb = u & 31;
#ifndef NO_ATTN
                    attn_unit(F, bh / HB, bh % HB, qb, lam, negM2, subln, 1.f - lam_init);
#endif
                }
              }
            }
            if (DBL == 32 && rep == 0) SEAM(3);
            }
            { PHASE_BEGIN();
              if (F.bid < 192 && (rep3 == 0 || (DBL3MASK & 2))) for (;;) {
                volatile LAS unsigned* MQ = (volatile LAS unsigned*)(F.lds + MISC_OFF);
                if (F.tid == 0) MQ[0] = __hip_atomic_fetch_add(F.ctl + CW_Q + 64 * (4 + l + 8 * rep3), 1u, RLX_AGENT);
                __syncthreads();
                const int u = (int)MQ[0];
                __syncthreads();
                if (u >= N_CVT_UNITS) break;
                convert_expert_unit(F, A, l, u);
              } }
        }
        }
        SEAM(3);
        if (IN(4)) { PHASE_BEGIN(); phase_delta_fin(F, (const float*)A->in[17] + l * 128); }
        SEAM(4);
        for (int rep_ = 0; rep_ < (DBL == 6 ? 2 : 1); ++rep_) {
        if (rep_) SEAM(6);
        if (IN(6)) { PHASE_BEGIN();
            SchedOutProj S{(const char*)(ws + WS_MMIX), (const char*)(ws + WS_WOUTT), F.G, F.bid};
            EpiOutProj E{(const unsigned char*)(ws + WS_GATES), (bf16*)(ws + WS_Z)};
            pg8::gemm_phase(F.lds, F.tid, D, D, S, E);
        }
        }
        SEAM(6);
        if (IN(7)) { PHASE_BEGIN();
            SchedPlain S{(const char*)(ws + WS_Z), (const char*)(ws + WS_WOT), D, D, 64, 8, 32, F.G, F.bid};
            EpiResid E{(l == 0) ? (const float*)A->in[0] : (const float*)A->out, A->out};
            pg8::gemm_phase(F.lds, F.tid, D, D, S, E);
        }
        SEAM(7);
        if (IN(8)) { PHASE_BEGIN(); phase_router(F, A->out, (const float*)A->in[24] + (size_t)l * D); }
        SEAM(8);
        if (IN(9)) { PHASE_BEGIN(); phase_topk(F); }
        SEAM(9);
        for (int rep_ = 0; rep_ < (DBL == 11 ? 2 : 1); ++rep_) {
        if (rep_) SEAM(11);
        if (IN(11)) { PHASE_BEGIN();
            SchedExpertGather S{(const char*)(ws + WS_XN), (const char*)(ws + WS_WGU), (const int*)(ws + WS_IDX), D, 32, F.G, F.bid};
            EpiSwiglu E{(bf16*)(ws + WS_HID)};
            pg8::gemm_phase<EpiSwiglu, SchedExpertGather, true>(F.lds, F.tid, D, D, S, E);
        }
        }
        SEAM(11);
        for (int rep_ = 0; rep_ < (DBL == 12 ? 2 : 1); ++rep_) {
        if (rep_) SEAM(12);
        if (IN(12)) { PHASE_BEGIN();
            SchedExpert S{(const char*)(ws + WS_HID), (const char*)(ws + WS_WDN), FF, FF, 16, F.G, F.bid};
            EpiDown E{(bf16*)(ws + WS_YSLOT), (const float*)(ws + WS_EW)};
            pg8::gemm_phase(F.lds, F.tid, FF, FF, S, E);
        }
        }
        SEAM(12);
        if (IN(13)) { PHASE_BEGIN(); phase_combine(F, A->out, (l + 1 < DEPTH) ? (const float*)A->in[2] + (size_t)(l + 1) * D : nullptr); if (l + 1 < DEPTH) { __syncthreads(); phase_convert(F, A, l + 1); __syncthreads(); } }
        if (l + 1 < DEPTH) SEAM(13);
#undef IN
#undef SEAM
#undef PHASE_BEGIN
}
template <int PSEL>
__global__ void __launch_bounds__(512, 2) fwd_kernel(Args args_unused) {
    extern __shared__ __attribute__((aligned(16))) unsigned char lds_raw[];
    const ArgsP kp = (ArgsP)__builtin_amdgcn_kernarg_segment_ptr();
    Frame F;
    F.lds = (LAS unsigned char*)lds_raw; F.ws = kp->ws; F.ctl = (unsigned*)(kp->ws + WS_CTL);
    F.tid = threadIdx.x; F.lane = F.tid & 63; F.wave = __builtin_amdgcn_readfirstlane(F.tid >> 6); F.bid = blockIdx.x; F.G = gridDim.x;
    volatile LAS unsigned* MISC = (volatile LAS unsigned*)(F.lds + MISC_OFF);
    if (F.tid < 32) MISC[F.tid] = 0u;
    __syncthreads();
    if (PSEL < 0) (void)xcd_barrier_post(F.ctl + CW_BAR, MISC + 8, F.tid);
    if (PSEL < 0) {
        unsigned long long pc; asm volatile("s_getpc_b64 %0" : "=s"(pc));
        const char* cb = (const char*)(pc & ~0xFFull);
        if (F.tid == 0) { const unsigned long long lim = (unsigned long long)(uintptr_t)cb + 321ull * 1024ull; MISC[20] = (unsigned)lim; MISC[21] = (unsigned)(lim >> 32); }
        const int slice = F.bid >> 3;
        f32x4 w0 = *(const f32x4*)(cb + ((size_t)slice * 512 + F.tid) * 16), w1 = w0;
        if (slice < 6) w1 = *(const f32x4*)(cb + 262144 + ((size_t)slice * 512 + F.tid) * 16);
        asm volatile("" :: "v"(w0), "v"(w1));
    }
    if (PSEL < 0) { layer_body<PSEL>(F, kp, 0); layer_body<PSEL>(F, kp, 1); }
    else layer_body<PSEL>(F, kp, kp->ph_lo);
}

static hipError_t set_lds_attr() {
    hipError_t e = hipSuccess;
#if MK_ONE_LAUNCH
    e = hipFuncSetAttribute((const void*)fwd_kernel<-1>, hipFuncAttributeMaxDynamicSharedMemorySize, LDS_BYTES);
#else
#define SA(p) if (e == hipSuccess) e = hipFuncSetAttribute((const void*)fwd_kernel<p>, hipFuncAttributeMaxDynamicSharedMemorySize, LDS_BYTES);
    SA(0) SA(1) SA(2) SA(3) SA(4) SA(5) SA(6) SA(7) SA(8) SA(9) SA(10) SA(11) SA(12) SA(13)
#undef SA
#endif
    return e;
}
extern "C" void kernel_launch(void* const* d_in, const int* in_sizes, int n_in, void* d_out, int out_size, void* d_ws, size_t ws_size, hipStream_t stream) {
    static int grid = 0;
    if (grid == 0) {
        if (n_in != 29 || out_size != M * D || ws_size < WS_END) { fprintf(stderr, "kernel_launch: unexpected shapes: n_in %d out %d ws %zu (need %zu)\n", n_in, out_size, ws_size, (size_t)WS_END); grid = -1; return; }
        int dev = 0, cus = 0;
        if (hipGetDevice(&dev) != hipSuccess || hipDeviceGetAttribute(&cus, hipDeviceAttributeMultiprocessorCount, dev) != hipSuccess) { grid = -1; return; }
        if (set_lds_attr() != hipSuccess) { fprintf(stderr, "kernel_launch: hipFuncSetAttribute failed\n"); grid = -1; return; }
        (void)hipGetLastError();
        grid = cus < 256 ? cus : 256;
    }
    if (grid < 0) return;
    (void)hipMemsetAsync((char*)d_ws + WS_CTL, 0, CTL_ZERO_BYTES, stream);
    Args a{};
    for (int i = 0; i < 29; ++i) a.in[i] = d_in[i];
    a.out = (float*)d_out; a.ws = (unsigned char*)d_ws;
#if MK_ONE_LAUNCH
    a.ph_lo = 0; a.ph_hi = DEPTH;
    hipLaunchKernelGGL(fwd_kernel<-1>, dim3(grid), dim3(512), LDS_BYTES, stream, a);
#else
    for (int l = 0; l < DEPTH; ++l) { a.ph_lo = l; a.ph_hi = l + 1;
#define LP(p) hipLaunchKernelGGL(fwd_kernel<p>, dim3(grid), dim3(512), LDS_BYTES, stream, a);
        LP(0) LP(1) LP(2) LP(3) LP(4) LP(5) LP(6) LP(7) LP(8) LP(9) LP(10) LP(11) LP(12) LP(13)
#undef LP
    }
#endif
}
```
